# Optimizing an MI355X kernel written in HIP

```python
import math
import jax, jax.numpy as jnp
from jax import lax
import numpy as np

D_MODEL = 2048
BATCH = 4
SEQ = 2048
DEPTH = 2

GRID_W = 64
CTX_LEN = 256
EPS = 1e-6
N_BRANCH = 4
ATTN_HEADS = 8
ATTN_KV_HEADS = 2
Q_PER_KV = ATTN_HEADS // ATTN_KV_HEADS
HEAD_DIM = 128
ROPE_THETA = 10000.0
Q_BLOCK = 128
RWKV_HEADS = 8
RWKV_HEAD = 64
RWKV_W = RWKV_HEADS * RWKV_HEAD
RWKV_DECAY_LORA = 64
RWKV_AAA_LORA = 64
RWKV_GATE_LORA = 128
RWKV_DECAY_SCALE = math.exp(-0.5)
RWKV_GN_EPS = 64e-5
MLSTM_HEADS = 4
MLSTM_HEAD = 128
MLSTM_W = MLSTM_HEADS * MLSTM_HEAD
MLSTM_CHUNK = 64
MLSTM_CONV = 3
MLSTM_NEG = -1e30
S5_W = 512
S5_GROUP = 16
S5_GROUPS = S5_W // S5_GROUP
S5_STATE = 64
FFN_HIDDEN = -(-8 * D_MODEL // (3 * 256)) * 256
ATTN_IN = (ATTN_HEADS + 2 * ATTN_KV_HEADS) * HEAD_DIM
RWKV_IN = 3 * RWKV_W + RWKV_DECAY_LORA + RWKV_AAA_LORA + RWKV_GATE_LORA
MLSTM_IN = 4 * MLSTM_W + 4 * MLSTM_HEADS
GATE_IN = N_BRANCH * D_MODEL
IN_GROUPS = (ATTN_IN, RWKV_IN, MLSTM_IN, S5_W, GATE_IN)
D_IN = ATTN_IN + RWKV_IN + MLSTM_IN + S5_W + GATE_IN

kernel_name = 'hybrid_flow_dit_block'


def rmsnorm(x, g):
    xf = x.astype(jnp.float32)
    y = xf * lax.rsqrt(jnp.mean(xf * xf, axis=-1, keepdims=True) + EPS)
    return (y * g.astype(jnp.float32)).astype(x.dtype)


def modulate(h, shift, scale):
    return h * (1 + scale) + shift


def split_cols(z, sizes):
    return jnp.split(z, np.cumsum(sizes)[:-1].tolist(), axis=-1)


def centred_dwconv(z, w):
    k = w.shape[0]
    pad = k // 2
    n = z.shape[1]
    zp = jnp.pad(z, ((0, 0), (pad, pad), (0, 0)))
    return sum(zp[:, j:j + n] * w[j] for j in range(k))


def bi_token_shift(z, mu):
    zp = jnp.pad(z, ((0, 0), (1, 1), (0, 0)))
    return z + mu * (0.5 * (zp[:, :-2] + zp[:, 2:]) - z)


def swiglu(h, w1, w2):
    a, b = jnp.split(h @ w1, 2, axis=-1)
    return (jax.nn.silu(a) * b) @ w2


def axial_rope_tables(n_tokens):
    rows = n_tokens // GRID_W
    row = jnp.repeat(jnp.arange(rows, dtype=jnp.float32), GRID_W)
    col = jnp.tile(jnp.arange(GRID_W, dtype=jnp.float32), rows)
    axis_dim = HEAD_DIM // 2
    inv_freq = ROPE_THETA ** (-jnp.arange(0, axis_dim, 2, dtype=jnp.float32) / axis_dim)
    ang_r = row[:, None] * inv_freq[None]
    ang_c = col[:, None] * inv_freq[None]
    return (jnp.cos(ang_r), jnp.sin(ang_r), jnp.cos(ang_c), jnp.sin(ang_c))


def _rotate(x, cos, sin):
    x1, x2 = jnp.split(x, 2, axis=-1)
    return jnp.concatenate([x1 * cos - x2 * sin, x1 * sin + x2 * cos], axis=-1)


def axial_rope(x, tables):
    extra = x.ndim - 3
    cr, sr, cc, sc = (t.reshape((t.shape[0],) + (1,) * extra + (t.shape[1],)) for t in tables)
    xr, xc = jnp.split(x.astype(jnp.float32), 2, axis=-1)
    return jnp.concatenate([_rotate(xr, cr, sr), _rotate(xc, cc, sc)], axis=-1).astype(x.dtype)


def _attend(q, k, v):
    s = jnp.einsum('bqkgd,bskd->bkgqs', q, k).astype(jnp.float32) * (HEAD_DIM ** -0.5)
    p = jax.nn.softmax(s, axis=-1).astype(v.dtype)
    return jnp.einsum('bkgqs,bskd->bqkgd', p, v)


def attention_mixer(zc, zl, q_g, k_g, rope):
    def heads(z):
        b, n = z.shape[:2]
        q, k, v = split_cols(z, (ATTN_HEADS * HEAD_DIM, ATTN_KV_HEADS * HEAD_DIM, ATTN_KV_HEADS * HEAD_DIM))
        q = rmsnorm(q.reshape(b, n, ATTN_KV_HEADS, Q_PER_KV, HEAD_DIM), q_g)
        k = rmsnorm(k.reshape(b, n, ATTN_KV_HEADS, HEAD_DIM), k_g)
        return q, k, v.reshape(b, n, ATTN_KV_HEADS, HEAD_DIM)
    qc, kc, vc = heads(zc)
    ql, kl, vl = heads(zl)
    ql = axial_rope(ql, rope)
    kl = axial_rope(kl, rope)
    b, n_ctx = zc.shape[:2]
    n_lat = zl.shape[1]
    yc = _attend(qc, kc, vc).reshape(b, n_ctx, -1)
    k_all = jnp.concatenate([kc, kl], axis=1)
    v_all = jnp.concatenate([vc, vl], axis=1)
    qb = jnp.moveaxis(ql.reshape(b, n_lat // Q_BLOCK, Q_BLOCK, ATTN_KV_HEADS, Q_PER_KV, HEAD_DIM), 1, 0)
    yl = lax.map(lambda q_blk: _attend(q_blk, k_all, v_all), qb)
    yl = jnp.moveaxis(yl, 0, 1).reshape(b, n_lat, -1)
    return yc, yl


def _rwkv_inputs(z, mu, w0, w_up, a0, a_up, g_up, k_k, k_a):
    b, n = z.shape[:2]
    hd = lambda t: t.reshape(b, n, RWKV_HEADS, RWKV_HEAD)
    z = bi_token_shift(z.astype(jnp.float32), mu)
    r, k, v, w_lo, a_lo, g_lo = split_cols(z, (RWKV_W, RWKV_W, RWKV_W, RWKV_DECAY_LORA, RWKV_AAA_LORA, RWKV_GATE_LORA))
    g = jax.nn.sigmoid(g_lo) @ g_up
    kk = hd(k * k_k)
    kk = kk * lax.rsqrt(jnp.sum(kk * kk, axis=-1, keepdims=True) + 1e-12)
    per_dir = []
    for d in range(2):
        w = jnp.exp(-RWKV_DECAY_SCALE * jax.nn.sigmoid(w0[d] + jnp.tanh(w_lo) @ w_up[d]))
        a = jax.nn.sigmoid(a0[d] + a_lo @ a_up[d])
        k_mod = k * (1 + (a - 1) * k_a)
        per_dir.append((hd(w), hd(a), hd(k_mod)))
    return hd(r), hd(v), kk, g, per_dir


def _rwkv_scan(r, w, kk, a, k, v, s0, reverse):
    xs = tuple(jnp.moveaxis(t, 1, 0) for t in (r, w, kk, a * kk, k, v))
    def step(s, inp):
        r_t, w_t, kk_t, b_t, k_t, v_t = inp
        s = (s * w_t[:, :, None, :]
             - jnp.einsum('bhvk,bhk->bhv', s, kk_t)[..., None] * b_t[:, :, None, :]
             + v_t[..., None] * k_t[:, :, None, :])
        return s, jnp.einsum('bhvk,bhk->bhv', s, r_t)
    s, o = lax.scan(step, s0, xs, reverse=reverse)
    return s, jnp.moveaxis(o, 0, 1)


def rwkv_mixer(zc, zl, mu, w0, w_up, a0, a_up, g_up, k_k, k_a, r_k, gn_g, gn_b):
    streams = [_rwkv_inputs(z, mu, w0, w_up, a0, a_up, g_up, k_k, k_a) for z in (zc, zl)]
    b = zl.shape[0]
    s0 = jnp.zeros((b, RWKV_HEADS, RWKV_HEAD, RWKV_HEAD), jnp.float32)
    outs = [0.0, 0.0]
    for d in range(2):
        s = s0
        for i, (r, v, kk, g, per_dir) in enumerate(streams):
            w, a, k_mod = per_dir[d]
            s, o = _rwkv_scan(r, w, kk, a, k_mod, v, s, d == 1)
            outs[i] = outs[i] + o + jnp.sum(r * k_mod * r_k, axis=-1, keepdims=True) * v
    results = []
    for (r, v, kk, g, _), o in zip(streams, outs):
        mean = jnp.mean(o, axis=-1, keepdims=True)
        var = jnp.mean(jnp.square(o - mean), axis=-1, keepdims=True)
        o = ((o - mean) * lax.rsqrt(var + RWKV_GN_EPS)).reshape(o.shape[0], o.shape[1], RWKV_W)
        results.append((o * gn_g + gn_b) * g)
    return results[0], results[1]


def _mlstm_chunked(q, k, v, ig, lf, state):
    b, h, n, dh = q.shape
    nc = n // MLSTM_CHUNK
    def chunks(t):
        return jnp.moveaxis(t.reshape((b, h, nc, MLSTM_CHUNK) + t.shape[3:]), 2, 0)
    lower = jnp.tril(jnp.ones((MLSTM_CHUNK, MLSTM_CHUNK), dtype=bool))
    def step(carry, inp):
        c_mat, n_vec, m = carry
        q_c, k_c, v_c, i_c, f_c = inp
        cum = jnp.cumsum(f_c, axis=-1)
        log_w = jnp.where(lower, cum[..., :, None] - cum[..., None, :] + i_c[..., None, :], MLSTM_NEG)
        m_inter = cum + m[..., None]
        m_t = jnp.maximum(jnp.max(log_w, axis=-1), m_inter)
        s = jnp.einsum('bhtd,bhsd->bhts', q_c, k_c) * jnp.exp(log_w - m_t[..., None])
        w_inter = jnp.exp(m_inter - m_t)
        num = jnp.einsum('bhts,bhsd->bhtd', s, v_c) + w_inter[..., None] * jnp.einsum('bhvk,bhtk->bhtv', c_mat, q_c)
        den = jnp.sum(s, axis=-1) + w_inter * jnp.einsum('bhk,bhtk->bht', n_vec, q_c)
        h_c = num / jnp.maximum(jnp.abs(den), jnp.exp(-m_t))[..., None]
        total = cum[..., -1]
        log_src = total[..., None] - cum + i_c
        m_new = jnp.maximum(total + m, jnp.max(log_src, axis=-1))
        src = jnp.exp(log_src - m_new[..., None])
        decay = jnp.exp(total + m - m_new)
        c_mat = decay[..., None, None] * c_mat + jnp.einsum('bhs,bhsv,bhsk->bhvk', src, v_c, k_c)
        n_vec = decay[..., None] * n_vec + jnp.einsum('bhs,bhsk->bhk', src, k_c)
        return (c_mat, n_vec, m_new), h_c
    state, hs = lax.scan(step, state, tuple(chunks(t) for t in (q, k, v, ig, lf)))
    return jnp.moveaxis(hs, 0, 2).reshape(b, h, n, dh), state


def mlstm_mixer(zc, zl, conv_w, i_b, f_b, gn_g):
    def prep(z):
        b, n = z.shape[:2]
        q, k, v, o, ig, fg = split_cols(z, (MLSTM_W,) * 4 + (2 * MLSTM_HEADS,) * 2)
        q, k = jnp.split(jax.nn.silu(centred_dwconv(jnp.concatenate([q, k], axis=-1), conv_w)), 2, axis=-1)
        hd = lambda t: jnp.moveaxis(t.astype(jnp.float32).reshape(b, n, MLSTM_HEADS, MLSTM_HEAD), 1, 2)
        gate = lambda t, bias: jnp.moveaxis(t.astype(jnp.float32).reshape(b, n, 2, MLSTM_HEADS) + bias, 1, -1)
        return (hd(q), hd(k) * MLSTM_HEAD ** -0.5, hd(v), gate(ig, i_b),
                jax.nn.log_sigmoid(gate(fg, f_b)), jax.nn.sigmoid(o.astype(jnp.float32)))
    streams = [prep(zc), prep(zl)]
    b = zl.shape[0]
    state0 = (jnp.zeros((b, MLSTM_HEADS, MLSTM_HEAD, MLSTM_HEAD), jnp.float32),
              jnp.zeros((b, MLSTM_HEADS, MLSTM_HEAD), jnp.float32),
              jnp.zeros((b, MLSTM_HEADS), jnp.float32))
    hsum = [0.0, 0.0]
    for d in range(2):
        flip = (lambda t: jnp.flip(t, axis=2)) if d == 1 else (lambda t: t)
        state = state0
        for i, (q, k, v, ig, lf, _) in enumerate(streams):
            h, state = _mlstm_chunked(flip(q), flip(k), flip(v), flip(ig[:, d]), flip(lf[:, d]), state)
            hsum[i] = hsum[i] + flip(h)
    results = []
    for stream, h in zip(streams, hsum):
        bb, _, n, _ = h.shape
        h = stream[5] * jnp.moveaxis(h, 1, 2).reshape(bb, n, MLSTM_W)
        hh = h.reshape(bb, n, MLSTM_HEADS, MLSTM_HEAD)
        mean = jnp.mean(hh, axis=-1, keepdims=True)
        var = jnp.mean(jnp.square(hh - mean), axis=-1, keepdims=True)
        results.append(((hh - mean) * lax.rsqrt(var + EPS)).reshape(bb, n, MLSTM_W) * gn_g)
    return results[0], results[1]


def _s5_discretise(lam_re, lam_im, log_step, b_re, b_im):
    lam_re, lam_im, b_re, b_im = (t.astype(jnp.float32) for t in (lam_re, lam_im, b_re, b_im))
    dt = jnp.exp(log_step.astype(jnp.float32))[:, None]
    mag = jnp.exp(lam_re * dt)
    a_re = mag * jnp.cos(lam_im * dt)
    a_im = mag * jnp.sin(lam_im * dt)
    den = lam_re * lam_re + lam_im * lam_im
    f_re = ((a_re - 1) * lam_re + a_im * lam_im) / den
    f_im = (a_im * lam_re - (a_re - 1) * lam_im) / den
    bb_re = f_re[..., None] * b_re - f_im[..., None] * b_im
    bb_im = f_re[..., None] * b_im + f_im[..., None] * b_re
    return a_re, a_im, bb_re, bb_im


def _complex_affine_combine(e1, e2):
    a1r, a1i, b1r, b1i = e1
    a2r, a2i, b2r, b2i = e2
    return (a1r * a2r - a1i * a2i, a1r * a2i + a1i * a2r,
            a2r * b1r - a2i * b1i + b2r, a2r * b1i + a2i * b1r + b2i)


def _s5_scan(u, a_re, a_im, bb_re, bb_im, x0_re, x0_im):
    bu_re = jnp.einsum('gpc,btgc->btgp', bb_re, u)
    bu_im = jnp.einsum('gpc,btgc->btgp', bb_im, u)
    bu_re = bu_re.at[:, 0].add(a_re * x0_re - a_im * x0_im)
    bu_im = bu_im.at[:, 0].add(a_re * x0_im + a_im * x0_re)
    elems = (jnp.broadcast_to(a_re, bu_re.shape), jnp.broadcast_to(a_im, bu_im.shape), bu_re, bu_im)
    _, _, x_re, x_im = lax.associative_scan(_complex_affine_combine, elems, axis=1)
    return x_re, x_im


def s5_mixer(zc, zl, lam_re, lam_im, log_step, b_re, b_im, c_re, c_im, d_skip, w_glu):
    us = [z.astype(jnp.float32).reshape(z.shape[0], z.shape[1], S5_GROUPS, S5_GROUP) for z in (zc, zl)]
    b = zl.shape[0]
    zero = jnp.zeros((b, S5_GROUPS, S5_STATE), jnp.float32)
    ys = [0.0, 0.0]
    for d in range(2):
        flip = (lambda t: jnp.flip(t, axis=1)) if d == 1 else (lambda t: t)
        a_re, a_im, bb_re, bb_im = _s5_discretise(lam_re[d], lam_im[d], log_step[d], b_re[d], b_im[d])
        cr = c_re[d].astype(jnp.float32)
        ci = c_im[d].astype(jnp.float32)
        x0 = (zero, zero)
        for i, u in enumerate(us):
            x_re, x_im = _s5_scan(flip(u), a_re, a_im, bb_re, bb_im, x0[0], x0[1])
            x0 = (x_re[:, -1], x_im[:, -1])
            y = jnp.einsum('gcp,btgp->btgc', cr, x_re) - jnp.einsum('gcp,btgp->btgc', ci, x_im)
            ys[i] = ys[i] + flip(y)
    outs = []
    d_g = d_skip.astype(jnp.float32).reshape(S5_GROUPS, S5_GROUP)
    for u, y in zip(us, ys):
        bb, n = u.shape[:2]
        y = (y + u * d_g).reshape(bb, n, S5_W)
        gl, gt = jnp.split(jax.nn.gelu(y) @ w_glu.astype(jnp.float32), 2, axis=-1)
        outs.append(gl * jax.nn.sigmoid(gt))
    return outs[0], outs[1]


def gated_merge(z_gate, b_gate, branches, w_branches, w_out):
    gates = jnp.split(jax.nn.sigmoid((z_gate + b_gate).astype(jnp.float32)), N_BRANCH, axis=-1)
    dt = z_gate.dtype
    y = sum(g.astype(dt) * (br.astype(dt) @ w) for g, br, w in zip(gates, branches, w_branches))
    return y @ w_out


def setup_inputs(seed: int = 0) -> dict:
    key = jax.random.key(seed)
    keys = iter(jax.random.split(key, 64))
    def nrm(shape, scale):
        return scale * jax.random.normal(next(keys), shape, jnp.float32)
    def gain(shape):
        return 1.0 + nrm(shape, 0.05)
    L, D = DEPTH, D_MODEL
    G, P, C5 = S5_GROUPS, S5_STATE, S5_GROUP
    n_idx = jnp.arange(P, dtype=jnp.float32)
    return {
        'x': nrm((BATCH, SEQ, D), 1.0),
        'c': nrm((BATCH, D), 1.0),
        'ctx': nrm((BATCH, CTX_LEN, D), 1.0),
        'c_ctx': nrm((D,), 1.0),
        'w_mod': nrm((L, D, 6 * D), 0.5 * D ** -0.5),
        'b_mod': nrm((L, 6 * D), 0.02),
        'norm1_g': gain((L, D)),
        'norm2_g': gain((L, D)),
        'w_in': nrm((L, D, D_IN), D ** -0.5),
        'b_gate': nrm((L, GATE_IN), 0.02),
        'q_norm_g': gain((L, HEAD_DIM)),
        'k_norm_g': gain((L, HEAD_DIM)),
        'rwkv_mu': jax.random.uniform(next(keys), (L, RWKV_IN), jnp.float32),
        'rwkv_w0': nrm((L, 2, RWKV_W), 1.0),
        'rwkv_w_up': nrm((L, 2, RWKV_DECAY_LORA, RWKV_W), 0.1),
        'rwkv_a0': nrm((L, 2, RWKV_W), 0.5),
        'rwkv_a_up': nrm((L, 2, RWKV_AAA_LORA, RWKV_W), 0.1),
        'rwkv_g_up': nrm((L, RWKV_GATE_LORA, RWKV_W), RWKV_GATE_LORA ** -0.5),
        'rwkv_k_k': 0.85 + nrm((L, RWKV_W), 0.05),
        'rwkv_k_a': 1.0 + nrm((L, RWKV_W), 0.05),
        'rwkv_r_k': nrm((L, RWKV_HEADS, RWKV_HEAD), 0.1),
        'rwkv_gn_g': gain((L, RWKV_W)),
        'rwkv_gn_b': nrm((L, RWKV_W), 0.02),
        'mlstm_conv_w': nrm((L, MLSTM_CONV, 2 * MLSTM_W), MLSTM_CONV ** -0.5),
        'mlstm_i_b': nrm((L, 2, MLSTM_HEADS), 0.1),
        'mlstm_f_b': 3.0 + nrm((L, 2, MLSTM_HEADS), 0.5),
        'mlstm_gn_g': gain((L, MLSTM_W)),
        's5_lam_re': -0.5 * jnp.exp(nrm((L, 2, G, P), 0.05)),
        's5_lam_im': jnp.pi * n_idx * (1.0 + nrm((L, 2, G, P), 0.01)),
        's5_log_step': jax.random.uniform(next(keys), (L, 2, G), jnp.float32, math.log(1e-3), math.log(1e-1)),
        's5_b_re': nrm((L, 2, G, P, C5), (2 * C5) ** -0.5),
        's5_b_im': nrm((L, 2, G, P, C5), (2 * C5) ** -0.5),
        's5_c_re': nrm((L, 2, G, C5, P), P ** -0.5),
        's5_c_im': nrm((L, 2, G, C5, P), P ** -0.5),
        's5_d': nrm((L, S5_W), 1.0),
        's5_w_glu': nrm((L, S5_W, 2 * S5_W), S5_W ** -0.5),
        'w_br_attn': nrm((L, ATTN_HEADS * HEAD_DIM, D), (ATTN_HEADS * HEAD_DIM) ** -0.5),
        'w_br_rwkv': nrm((L, RWKV_W, D), RWKV_W ** -0.5),
        'w_br_mlstm': nrm((L, MLSTM_W, D), MLSTM_W ** -0.5),
        'w_br_s5': nrm((L, S5_W, D), S5_W ** -0.5),
        'w_out': nrm((L, D, D), D ** -0.5),
        'w_ffn_in': nrm((L, D, 2 * FFN_HIDDEN), D ** -0.5),
        'w_ffn_out': nrm((L, FFN_HIDDEN, D), FFN_HIDDEN ** -0.5),
        'final_norm_g': gain((D,)),
    }


def reference(x, c, ctx, c_ctx, w_mod, b_mod, norm1_g, norm2_g, w_in, b_gate, q_norm_g, k_norm_g,
              rwkv_mu, rwkv_w0, rwkv_w_up, rwkv_a0, rwkv_a_up, rwkv_g_up, rwkv_k_k, rwkv_k_a, rwkv_r_k,
              rwkv_gn_g, rwkv_gn_b, mlstm_conv_w, mlstm_i_b, mlstm_f_b, mlstm_gn_g,
              s5_lam_re, s5_lam_im, s5_log_step, s5_b_re, s5_b_im, s5_c_re, s5_c_im, s5_d, s5_w_glu,
              w_br_attn, w_br_rwkv, w_br_mlstm, w_br_s5, w_out, w_ffn_in, w_ffn_out, final_norm_g):
    rope = axial_rope_tables(x.shape[1])
    xc, xl = ctx, x
    for l in range(DEPTH):
        mod_l = jnp.split((jax.nn.silu(c) @ w_mod[l] + b_mod[l])[:, None, :], 6, axis=-1)
        mod_c = jnp.split((jax.nn.silu(c_ctx) @ w_mod[l] + b_mod[l])[None, None, :], 6, axis=-1)
        hc = modulate(rmsnorm(xc, norm1_g[l]), mod_c[0], mod_c[1])
        hl = modulate(rmsnorm(xl, norm1_g[l]), mod_l[0], mod_l[1])
        zc = split_cols(hc @ w_in[l], IN_GROUPS)
        zl = split_cols(hl @ w_in[l], IN_GROUPS)
        ya = attention_mixer(zc[0], zl[0], q_norm_g[l], k_norm_g[l], rope)
        yr = rwkv_mixer(zc[1], zl[1], rwkv_mu[l], rwkv_w0[l], rwkv_w_up[l], rwkv_a0[l], rwkv_a_up[l],
                        rwkv_g_up[l], rwkv_k_k[l], rwkv_k_a[l], rwkv_r_k[l], rwkv_gn_g[l], rwkv_gn_b[l])
        ym = mlstm_mixer(zc[2], zl[2], mlstm_conv_w[l], mlstm_i_b[l], mlstm_f_b[l], mlstm_gn_g[l])
        ys = s5_mixer(zc[3], zl[3], s5_lam_re[l], s5_lam_im[l], s5_log_step[l], s5_b_re[l], s5_b_im[l],
                      s5_c_re[l], s5_c_im[l], s5_d[l], s5_w_glu[l])
        w_branches = (w_br_attn[l], w_br_rwkv[l], w_br_mlstm[l], w_br_s5[l])
        xl = xl + mod_l[2] * gated_merge(zl[4], b_gate[l], (ya[1], yr[1], ym[1], ys[1]), w_branches, w_out[l])
        xl = xl + mod_l[5] * swiglu(modulate(rmsnorm(xl, norm2_g[l]), mod_l[3], mod_l[4]), w_ffn_in[l], w_ffn_out[l])
        if l < DEPTH - 1:
            xc = xc + mod_c[2] * gated_merge(zc[4], b_gate[l], (ya[0], yr[0], ym[0], ys[0]), w_branches, w_out[l])
            xc = xc + mod_c[5] * swiglu(modulate(rmsnorm(xc, norm2_g[l]), mod_c[3], mod_c[4]), w_ffn_in[l], w_ffn_out[l])
    return rmsnorm(xl, final_norm_g)
```

```cpp
#include <hip/hip_runtime.h>
#include <hip/hip_cooperative_groups.h>
#include <cstdio>
#include <cstdint>
namespace cg = cooperative_groups;
extern __shared__ __attribute__((aligned(16))) unsigned char shm[];
constexpr int LDS_BYTES = 147456, WTAB_OFF = LDS_BYTES - 256;
__device__ __forceinline__ int hwslot() { return (int)(__builtin_amdgcn_s_getreg(4 | (0 << 6) | (5 << 11)) & 63u); }
__device__ __forceinline__ void otid_init() { if ((threadIdx.x & 63) == 0) ((int*)(shm + WTAB_OFF))[hwslot()] = (int)(threadIdx.x >> 6); __syncthreads(); }
__device__ __forceinline__ int otid() {
    const unsigned addr = (unsigned)(size_t)(__attribute__((address_space(3))) unsigned char*)shm + (unsigned)WTAB_OFF + 4u * (unsigned)hwslot();
    int w, lane;
    asm volatile("ds_read_b32 %0, %1\n\ts_waitcnt lgkmcnt(0)" : "=v"(w) : "v"(addr) : "memory");
    asm volatile("v_mbcnt_lo_u32_b32 %0, -1, 0\n\tv_mbcnt_hi_u32_b32 %0, -1, %0" : "=v"(lane));
    return (__builtin_amdgcn_readfirstlane(w) << 6) | lane; }
__device__ __forceinline__ int obid() { int t = (int)blockIdx.x; asm volatile("" : "+s"(t)); return t; }
namespace pg8 {
#define PG8_LAS __attribute__((address_space(3)))
typedef unsigned short bf16_t;
typedef short bf16x8 __attribute__((ext_vector_type(8)));
typedef float f32x4 __attribute__((ext_vector_type(4)));
typedef unsigned u32x4 __attribute__((ext_vector_type(4)));
constexpr int BM = 256, BK = 64, HALF = 128, HTB = HALF * BK * 2  , STAGE_BYTES = 8 * HTB, NXCD = 8, WGM = 8;

__host__ __device__ __forceinline__ int lds_byte(int r, int c) { const int st = (r >> 4) * 2 + (c >> 5), rr = r & 15, cc = c & 31, ob = rr * 64 + cc * 2; return st * 1024 + (ob ^ (((ob >> 9) & 1) << 5)); }
__host__ __device__ __forceinline__ void stage_rc(int b, int& R, int& C) { const int st = b / 1024, sb = b % 1024, swz = sb ^ (((sb >> 9) & 1) << 5); R = (st >> 1) * 16 + swz / 64; C = (st & 1) * 32 + (swz % 64) / 2; }
__host__ __device__ __forceinline__ int perm32(int rho) { const int n = rho >> 4, i = rho & 15; return 8 * (i >> 2) + 4 * n + (i & 3); }

struct Unit { int pm, pn; };
struct Gemm { const bf16_t* A; const bf16_t* Bt; int M, N, K; };

struct Order {
    int nM, nN, nwg, G, c, skip;
    __device__ void init(int nM_, int N, int G_, int c_, int skip_) { nM = nM_; nN = N / BM; nwg = nM * nN; G = G_; c = c_; skip = skip_; }
    __device__ bool next(int i, Unit& u) const {
        const long L = (long)i * G + c; if (L >= nwg) return false;
        int wgid = (int)L; { const int q = nwg / NXCD, r = nwg % NXCD, xcd = wgid % NXCD, off = wgid / NXCD; wgid = (xcd < r ? xcd * (q + 1) : r * (q + 1) + (xcd - r) * q) + off; }
        const int nig = WGM * nN, gid = wgid / nig, fm = gid * WGM, gsz = (nM - fm) < WGM ? (nM - fm) : WGM;
        u.pm = fm + ((wgid % nig) % gsz); u.pn = (wgid % nig) / gsz;
        if (skip) u.pm = (u.pm >> 3) * 9 + 1 + (u.pm & 7);
        return true;
    }
    __device__ __forceinline__ void a_ready(const Unit&) const {}
    __device__ __forceinline__ void done(const Unit&) const {}
};
__device__ __forceinline__ unsigned cvt_pk_bf16(float lo, float hi) { unsigned r; asm volatile("v_cvt_pk_bf16_f32 %0, %1, %2" : "=v"(r) : "v"(lo), "v"(hi)); return r; }
template <class Epi, class Sched, bool STAMP = false>
__device__ __forceinline__ void gemm_phase(PG8_LAS unsigned char* lds, const Gemm g, const Sched& S, const Epi& E, unsigned long long* stamps) {
    const int tid = otid(), wid = __builtin_amdgcn_readfirstlane(tid >> 6), lane = tid & 63, wr = wid >> 2, wc = wid & 3, fr = lane & 15, fq = lane >> 4;
    const int K = g.K, nt = K / BK;
    int ts_lo = 0, ts_hi = 0, nts = 0; const unsigned long long rt_entry = STAMP ? (unsigned long long)wall_clock64() : 0ull;
#define PG8_STAMP() do { if (STAMP && wid == 0 && nts < 64) { const unsigned long long _c = (unsigned long long)clock64(); \
        ts_lo = (lane == nts) ? (int)(unsigned)_c : ts_lo; ts_hi = (lane == nts) ? (int)(unsigned)(_c >> 32) : ts_hi; ++nts; } } while (0)
    PG8_STAMP();
    unsigned voffA[2], voffB[2];
#pragma unroll
    for (int i = 0; i < 2; ++i) { int R, C; stage_rc(tid * 16 + i * 8192, R, C); const int Rb = Epi::PERM ? ((R & ~31) + perm32(R & 31)) : R;
        voffA[i] = (unsigned)(R * K + C) * 2u; voffB[i] = (unsigned)(Rb * K + C) * 2u; }
    const size_t kstep = (size_t)(BK * 2);
    const size_t hstep = (size_t)HALF * K * 2;
    const size_t tstep = 2 * hstep;
    const unsigned ldsw = (unsigned)wid * 1024u;
    const int aoff = lds_byte(wr * 64 + fr, fq * 8), boff = lds_byte(wc * 32 + fr, fq * 8);
#define PG8_SA(b, h) (((b) * 2 + (h)) * HTB)
#define PG8_SB(b, h) ((4 + (b) * 2 + (h)) * HTB)
#define PG8_STAGE(bufoff, gbase, voff) do { _Pragma("unroll") for (int _i = 0; _i < 2; ++_i) \
        __builtin_amdgcn_global_load_lds((const unsigned*)((const char*)(gbase) + (voff)[_i]), (PG8_LAS unsigned*)(lds + (bufoff) + ldsw + _i * 8192), 16, 0, 0); } while (0)
#define PG8_LDA(dst, b, h) do { _Pragma("unroll") for (int m = 0; m < 4; ++m) _Pragma("unroll") for (int k = 0; k < 2; ++k) dst[m][k] = *(const PG8_LAS bf16x8*)(lds + PG8_SA(b, h) + aoff + m * 2048 + k * 1024); } while (0)
#define PG8_LDB(dst, b, h) do { _Pragma("unroll") for (int n = 0; n < 2; ++n) _Pragma("unroll") for (int k = 0; k < 2; ++k) dst[n][k] = *(const PG8_LAS bf16x8*)(lds + PG8_SB(b, h) + boff + n * 2048 + k * 1024); } while (0)
#define PG8_MMA(ai, bj, At, Bt) do { __builtin_amdgcn_s_setprio(1); _Pragma("unroll") for (int m = 0; m < 4; ++m) _Pragma("unroll") for (int n = 0; n < 2; ++n) _Pragma("unroll") for (int k = 0; k < 2; ++k) \
        acc[ai][bj][m][n] = __builtin_amdgcn_mfma_f32_16x16x32_bf16(Bt[n][k], At[m][k], acc[ai][bj][m][n], 0, 0, 0); __builtin_amdgcn_s_setprio(0); } while (0)
#define PG8_WAIT_V(n) asm volatile("s_waitcnt vmcnt(" #n ")" ::: "memory")
#define PG8_WAIT_L(n) asm volatile("s_waitcnt lgkmcnt(" #n ")" ::: "memory")
#define PG8_BAR __builtin_amdgcn_s_barrier()
#define PG8_SCHED __builtin_amdgcn_sched_barrier(0)
    Unit cur, nxt; int ui = 0;
    if (!S.next(0, cur)) return;
    f32x4 acc[2][2][4][2];
#pragma unroll
    for (int a = 0; a < 2; ++a)
#pragma unroll
        for (int b = 0; b < 2; ++b)
#pragma unroll
            for (int m = 0; m < 4; ++m)
#pragma unroll
                for (int n = 0; n < 2; ++n) acc[a][b][m][n] = (f32x4){0.f, 0.f, 0.f, 0.f};
    bf16x8 At[4][2], B0[2][2], B1[2][2];
    const char* cA = (const char*)g.A + (size_t)cur.pm * tstep; const char* cB = (const char*)g.Bt + (size_t)cur.pn * tstep;
    S.a_ready(cur);
    PG8_STAGE(PG8_SB(0, 0), cB, voffB); PG8_STAGE(PG8_SA(0, 0), cA, voffA); PG8_STAGE(PG8_SB(0, 1), cB + hstep, voffB); PG8_STAGE(PG8_SA(0, 1), cA + hstep, voffA);
    if (wr == 1) PG8_BAR;
    PG8_WAIT_V(4); PG8_BAR;
    PG8_STAGE(PG8_SB(1, 0), cB + kstep, voffB); PG8_STAGE(PG8_SA(1, 0), cA + kstep, voffA); PG8_STAGE(PG8_SB(1, 1), cB + hstep + kstep, voffB);
    PG8_WAIT_V(6); PG8_BAR;
    PG8_STAMP();
    for (;;) {
        const bool has_next = S.next(ui + 1, nxt);
        const char* nA = has_next ? (const char*)g.A + (size_t)nxt.pm * tstep : cA; const char* nB = has_next ? (const char*)g.Bt + (size_t)nxt.pn * tstep : cB;
        for (int t = 0; t < nt; t += 2) {
            const bool last = (t == nt - 2);
            const char* a1 = cA + (size_t)(t + 1) * kstep;
            const char* a2 = last ? nA : cA + (size_t)(t + 2) * kstep; const char* b2 = last ? nB : cB + (size_t)(t + 2) * kstep;
            const char* a3 = a2 + kstep; const char* b3 = b2 + kstep;
            if (last && has_next) S.a_ready(nxt);
            PG8_LDB(B0, 0, 0); PG8_SCHED; PG8_LDA(At, 0, 0); PG8_STAGE(PG8_SA(1, 1), a1 + hstep, voffA);
            PG8_WAIT_L(8); PG8_BAR; PG8_WAIT_L(0); PG8_MMA(0, 0, At, B0); PG8_BAR; PG8_SCHED;
            PG8_LDB(B1, 0, 1); PG8_STAGE(PG8_SB(0, 0), b2, voffB);
            PG8_BAR; PG8_WAIT_L(0); PG8_MMA(0, 1, At, B1); PG8_BAR;
            PG8_LDA(At, 0, 1); PG8_STAGE(PG8_SA(0, 0), a2, voffA);
            PG8_BAR; PG8_WAIT_L(0); PG8_MMA(1, 0, At, B0); PG8_BAR; PG8_SCHED;
            PG8_STAGE(PG8_SB(0, 1), b2 + hstep, voffB);
            PG8_WAIT_V(6); PG8_BAR; PG8_MMA(1, 1, At, B1); PG8_BAR;
            PG8_LDB(B0, 1, 0); PG8_SCHED; PG8_LDA(At, 1, 0); PG8_STAGE(PG8_SA(0, 1), a2 + hstep, voffA);
            PG8_WAIT_L(8); PG8_BAR; PG8_WAIT_L(0); PG8_MMA(0, 0, At, B0); PG8_BAR; PG8_SCHED;
            PG8_LDB(B1, 1, 1); PG8_STAGE(PG8_SB(1, 0), b3, voffB);
            PG8_BAR; PG8_WAIT_L(0); PG8_MMA(0, 1, At, B1); PG8_BAR;
            PG8_LDA(At, 1, 1); PG8_STAGE(PG8_SA(1, 0), a3, voffA);
            PG8_BAR; PG8_WAIT_L(0); PG8_MMA(1, 0, At, B0); PG8_BAR; PG8_SCHED;
            PG8_STAGE(PG8_SB(1, 1), b3 + hstep, voffB);
            PG8_WAIT_V(6); PG8_BAR; PG8_MMA(1, 1, At, B1); PG8_BAR;
        }
        PG8_STAMP();
        if constexpr (!Epi::AFTER_DRAIN) { E(acc, cur, wr, wc, fr, fq); S.done(cur); }
        PG8_STAMP();
        if (!has_next) break;
#pragma unroll
        for (int a = 0; a < 2; ++a)
#pragma unroll
            for (int b = 0; b < 2; ++b)
#pragma unroll
                for (int m = 0; m < 4; ++m)
#pragma unroll
                    for (int n = 0; n < 2; ++n) acc[a][b][m][n] = (f32x4){0.f, 0.f, 0.f, 0.f};
        cur = nxt; cA = nA; cB = nB; ++ui;
    }
    PG8_WAIT_V(0);
    if (wr == 0) PG8_BAR;
    PG8_BAR;
    if constexpr (Epi::AFTER_DRAIN) { E.fused(acc, cur, wr, wc, fr, fq, lds, wid, lane); S.done(cur); }
    PG8_STAMP();
    if (STAMP && wid == 0) { stamps[lane] = lane < nts ? (((unsigned long long)(unsigned)ts_hi << 32) | (unsigned)ts_lo) : 0ull;
        if (lane == 62) stamps[62] = rt_entry; if (lane == 63) stamps[63] = (unsigned long long)wall_clock64(); }
#undef PG8_STAMP
#undef PG8_SA
#undef PG8_SB
#undef PG8_STAGE
#undef PG8_LDA
#undef PG8_LDB
#undef PG8_MMA
#undef PG8_WAIT_V
#undef PG8_WAIT_L
#undef PG8_BAR
#undef PG8_SCHED
}
}

namespace att {
using bf16 = unsigned short;
constexpr int   D = 128, NW = 8, QBLK = 32, KVBLK = 64;
constexpr float SCALE = 0.088388347648318440f;
constexpr float THR = 8.f;
constexpr int SDEPTH = 2;
constexpr int LDQ = 1536, LDK = 1536, LDO = 1024;
constexpr size_t SHM_V = KVBLK * D * 2, SHM_K = KVBLK * D * 2, SHM_ATTN = 2 * SHM_V + 2 * SHM_K + NW * 64 * 4;
__device__ __forceinline__ unsigned short f2bf_att(float f) { unsigned u = __float_as_uint(f); u += 0x7FFFu + ((u >> 16) & 1u); return (unsigned short)(u >> 16); }
using bf16x8 = __attribute__((ext_vector_type(8))) short;
using s16x4  = __attribute__((ext_vector_type(4))) short;
using f32x16 = __attribute__((ext_vector_type(16))) float;
using f32x8  = __attribute__((ext_vector_type(8))) float;
using u32x4  = __attribute__((ext_vector_type(4))) unsigned;
#define KSWZ(row, colB) ((row) * 256 + ((colB) ^ (((row) & 7) << 4)))
#define SBAR() __builtin_amdgcn_sched_barrier(0)
__device__ __forceinline__ int crow(int r, int hi) { return (r & 3) + 8 * (r >> 2) + 4 * hi; }
__device__ __forceinline__ unsigned cvtpk(float lo, float hi) {
  unsigned r; asm volatile("v_cvt_pk_bf16_f32 %0, %1, %2" : "=v"(r) : "v"(lo), "v"(hi)); return r;
}
template <typename TIn> struct Stage;
template <> struct Stage<bf16>  { using T = bf16x8;
  __device__ static __forceinline__ T ld8(const bf16* p) { return *reinterpret_cast<const bf16x8*>(p); }
  __device__ static __forceinline__ bf16x8 tobf(T x) { return x; } };
template <> struct Stage<float> { using T = f32x8;
  __device__ static __forceinline__ T ld8(const float* p) { return *reinterpret_cast<const f32x8*>(p); }
  __device__ static __forceinline__ bf16x8 tobf(T x) {
    u32x4 w = {cvtpk(x[0], x[1]), cvtpk(x[2], x[3]), cvtpk(x[4], x[5]), cvtpk(x[6], x[7])}; return *reinterpret_cast<bf16x8*>(&w); } };

__device__ __forceinline__ void partialSM(f32x16& p0, f32x16& p1, float& m_reg, float& mn, float& alpha) {
  constexpr float C = SCALE * 1.4426950408889634f;
  float pmax = p0[0]; for (int r = 1; r < 16; ++r) pmax = fmaxf(pmax, p0[r]); for (int r = 0; r < 16; ++r) pmax = fmaxf(pmax, p1[r]);
  { auto rr = __builtin_amdgcn_permlane32_swap(__float_as_uint(pmax), __float_as_uint(pmax), false, false);
    pmax = fmaxf(__uint_as_float(rr[0]), __uint_as_float(rr[1])); }
  if (__builtin_expect(__all(pmax - m_reg <= THR / SCALE), 1)) { mn = m_reg; alpha = 1.f; }
  else { mn = fmaxf(m_reg, pmax); alpha = __builtin_amdgcn_exp2f((m_reg - mn) * C); m_reg = mn; }
  float mnC = -mn * C;
  for (int r = 0; r < 16; ++r) p0[r] = fmaf(p0[r], C, mnC); for (int r = 0; r < 16; ++r) p1[r] = fmaf(p1[r], C, mnC);
  for (int r = 0; r < 16; ++r) p0[r] = __builtin_amdgcn_exp2f(p0[r]);
}
__device__ __forceinline__ void finishSM(f32x16& p0, f32x16& p1, float alpha, float& l_reg, bf16x8& pa0, bf16x8& pa1, bf16x8& pa2, bf16x8& pa3) {
  for (int r = 0; r < 16; ++r) p1[r] = __builtin_amdgcn_exp2f(p1[r]);
  float ps = 0; for (int r = 0; r < 16; ++r) ps += p0[r]; for (int r = 0; r < 16; ++r) ps += p1[r];
  { auto rr = __builtin_amdgcn_permlane32_swap(__float_as_uint(ps), __float_as_uint(ps), false, false);
    ps = __uint_as_float(rr[0]) + __uint_as_float(rr[1]); }
  l_reg = l_reg * alpha + ps;
#define PK4(P, BASE, OUT) do { unsigned a0 = cvtpk(P[BASE + 0], P[BASE + 1]), a1 = cvtpk(P[BASE + 2], P[BASE + 3]);   \
    unsigned b0 = cvtpk(P[BASE + 4], P[BASE + 5]), b1 = cvtpk(P[BASE + 6], P[BASE + 7]);                              \
    auto r0 = __builtin_amdgcn_permlane32_swap(a0, b0, false, false); auto r1 = __builtin_amdgcn_permlane32_swap(a1, b1, false, false); \
    u32x4 w = {r0[0], r1[0], r0[1], r1[1]}; OUT = *reinterpret_cast<bf16x8*>(&w); } while (0)
  PK4(p0, 0, pa0); PK4(p0, 8, pa1); PK4(p1, 0, pa2); PK4(p1, 8, pa3);
#undef PK4
}
__device__ __forceinline__ void qkt(f32x16& p0, f32x16& p1, const bf16* Ks, const bf16x8* qr, int r32, int hi) {
  p0 = f32x16{}; p1 = f32x16{};
  for (int d0 = 0; d0 < 8; ++d0) { int cb = (d0 * 16 + hi * 8) * 2;
    bf16x8 b0 = *reinterpret_cast<const bf16x8*>((const char*)Ks + KSWZ(r32, cb));
    bf16x8 b1 = *reinterpret_cast<const bf16x8*>((const char*)Ks + KSWZ(32 + r32, cb));
    p0 = __builtin_amdgcn_mfma_f32_32x32x16_bf16(b0, qr[d0], p0, 0, 0, 0);
    p1 = __builtin_amdgcn_mfma_f32_32x32x16_bf16(b1, qr[d0], p1, 0, 0, 0); }
}
__device__ __forceinline__ int v_st(int k, int c) { const int kk = (k & ~0xC) | ((k & 4) << 1) | ((k & 8) >> 1); return ((kk >> 3) * 4 + (c >> 5)) * 512 + ((kk & 7) * 32 + (c & 31)) * 2; }
__device__ __forceinline__ int v_rd_base(int lane) { return ((lane & 3) << 3) | (((lane >> 2) & 3) << 6) | (((lane >> 4) & 1) << 5) | (((lane >> 5) & 1) << 8); }
constexpr int v_rd_off(int d0, int ks, int half) { return d0 * 512 + ks * 4096 + half * 2048; }
template <int OFF> __device__ __forceinline__ s16x4 tr_read(int vb) {
  s16x4 r; asm volatile("ds_read_b64_tr_b16 %0, %1 offset:%2" : "=&v"(r) : "v"(vb), "i"(OFF) : "memory"); return r;
}
template <int D0> __device__ __forceinline__ void pv_one(f32x16& od, int vb, bf16x8 pa0, bf16x8 pa1, bf16x8 pa2, bf16x8 pa3) {
  const s16x4 l0 = tr_read<v_rd_off(D0, 0, 0)>(vb), h0 = tr_read<v_rd_off(D0, 0, 1)>(vb), l1 = tr_read<v_rd_off(D0, 1, 0)>(vb), h1 = tr_read<v_rd_off(D0, 1, 1)>(vb);
  const s16x4 l2 = tr_read<v_rd_off(D0, 2, 0)>(vb), h2 = tr_read<v_rd_off(D0, 2, 1)>(vb), l3 = tr_read<v_rd_off(D0, 3, 0)>(vb), h3 = tr_read<v_rd_off(D0, 3, 1)>(vb);
  asm volatile("s_waitcnt lgkmcnt(0)" ::: "memory"); SBAR();
#define PK(L, H) (bf16x8){L[0], L[1], L[2], L[3], H[0], H[1], H[2], H[3]}
  od = __builtin_amdgcn_mfma_f32_32x32x16_bf16(pa0, PK(l0, h0), od, 0, 0, 0);
  od = __builtin_amdgcn_mfma_f32_32x32x16_bf16(pa1, PK(l1, h1), od, 0, 0, 0);
  od = __builtin_amdgcn_mfma_f32_32x32x16_bf16(pa2, PK(l2, h2), od, 0, 0, 0);
  od = __builtin_amdgcn_mfma_f32_32x32x16_bf16(pa3, PK(l3, h3), od, 0, 0, 0);
#undef PK
}
__device__ __forceinline__ void pv_d0(f32x16* o, int vb, bf16x8 pa0, bf16x8 pa1, bf16x8 pa2, bf16x8 pa3) {
  pv_one<0>(o[0], vb, pa0, pa1, pa2, pa3); pv_one<1>(o[1], vb, pa0, pa1, pa2, pa3); pv_one<2>(o[2], vb, pa0, pa1, pa2, pa3); pv_one<3>(o[3], vb, pa0, pa1, pa2, pa3);
}

template <typename TQ>
__device__ __forceinline__ void attn_dense_body(const TQ* __restrict__ Qb, const bf16* __restrict__ Kh, const bf16* __restrict__ Vh,
                                                bf16* __restrict__ Ob, int seq, char* lds) {
  using St = Stage<bf16>; using SQ = Stage<TQ>;
  const int tid = otid(), wid = tid >> 6, lane = tid & 63, r32 = lane & 31, hi = lane >> 5;
  bf16* V_lds = (bf16*)lds; bf16* K_lds = (bf16*)(lds + 2 * SHM_V);
  float* ws = (float*)(lds + 2 * SHM_V + 2 * SHM_K) + wid * 64; float* li_l = ws; float* al_l = ws + 32;
  float m_reg = -1e30f, l_reg = 0; f32x16 o[4] = {}; bf16x8 qr[8];
  const TQ* Qw = Qb + (int)(wid * QBLK + r32) * LDQ + hi * 8;
#pragma unroll
  for (int d0 = 0; d0 < 8; ++d0) qr[d0] = SQ::tobf(SQ::ld8(Qw + d0 * 16));
  const int sr = tid >> 4, sc = (tid & 15) * 8, vst0 = v_st(sr, sc), vst1 = v_st(32 + sr, sc);
  const int vb0 = (int)(uintptr_t)V_lds + v_rd_base(lane);
  struct { typename St::T vs0, vs1, ks0, ks1; } sr_[SDEPTH];
#define SLOAD(i, k0) do { sr_[i].vs0 = St::ld8(&Vh[(int)((k0) + sr) * LDK + sc]); sr_[i].vs1 = St::ld8(&Vh[(int)((k0) + 32 + sr) * LDK + sc]); \
    sr_[i].ks0 = St::ld8(&Kh[(int)((k0) + sr) * LDK + sc]); sr_[i].ks1 = St::ld8(&Kh[(int)((k0) + 32 + sr) * LDK + sc]); } while (0)
#define SWRITE(b, i) do { *(bf16x8*)((char*)V_lds + (b) * SHM_V + vst0) = St::tobf(sr_[i].vs0);          \
    *(bf16x8*)((char*)V_lds + (b) * SHM_V + vst1) = St::tobf(sr_[i].vs1); int kc = sc * 2;               \
    *(bf16x8*)((char*)K_lds + (b) * SHM_K + KSWZ(sr, kc)) = St::tobf(sr_[i].ks0);                       \
    *(bf16x8*)((char*)K_lds + (b) * SHM_K + KSWZ(32 + sr, kc)) = St::tobf(sr_[i].ks1); } while (0)
#define SWAIT() do { if constexpr (SDEPTH == 2) asm volatile("s_waitcnt vmcnt(4)" ::: "memory"); else asm volatile("s_waitcnt vmcnt(0)" ::: "memory"); } while (0)
#define RESC(a) do { if (__any((a) < 1.f)) { if (hi == 0) al_l[r32] = (a); asm volatile("s_waitcnt lgkmcnt(0)" ::: "memory"); \
    for (int d = 0; d < 4; ++d) for (int r = 0; r < 16; ++r) o[d][r] *= al_l[crow(r, hi)]; } } while (0)
  f32x16 pA0, pA1, pB0, pB1; float mnA, mnB, alA, alB; bf16x8 pa0, pa1, pa2, pa3; const int NT = seq / KVBLK;
  constexpr int SE = 0, SO = SDEPTH - 1;
  SLOAD(SE, 0); asm volatile("s_waitcnt vmcnt(0)" ::: "memory"); SWRITE(0, SE); __syncthreads();
  qkt(pA0, pA1, K_lds, qr, r32, hi); partialSM(pA0, pA1, m_reg, mnA, alA);
  SLOAD(SO, KVBLK); if constexpr (SDEPTH == 2) { if (2 < NT) SLOAD(SE, 2 * KVBLK); }
  SWAIT(); SWRITE(1, SO); __syncthreads();
  for (int j = 1; j + 1 < NT; j += 2) {
    SBAR(); qkt(pB0, pB1, (bf16*)((char*)K_lds + SHM_K), qr, r32, hi);
    finishSM(pA0, pA1, alA, l_reg, pa0, pa1, pa2, pa3); SBAR();
    SLOAD(SO, (j + SDEPTH) * KVBLK); SBAR();
    pv_d0(o, vb0, pa0, pa1, pa2, pa3); partialSM(pB0, pB1, m_reg, mnB, alB);
    __syncthreads(); SWAIT(); SWRITE(0, SE);
    RESC(alB); __syncthreads();
    SBAR(); qkt(pA0, pA1, K_lds, qr, r32, hi);
    finishSM(pB0, pB1, alB, l_reg, pa0, pa1, pa2, pa3); SBAR();
    if (SDEPTH == 1 || j + 3 < NT) SLOAD(SE, (j + 1 + SDEPTH) * KVBLK); SBAR();
    pv_d0(o, vb0 + (int)SHM_V, pa0, pa1, pa2, pa3); partialSM(pA0, pA1, m_reg, mnA, alA);
    __syncthreads(); SWAIT(); SWRITE(1, SO);
    RESC(alA); __syncthreads();
  }
  SBAR(); qkt(pB0, pB1, (bf16*)((char*)K_lds + SHM_K), qr, r32, hi);
  finishSM(pA0, pA1, alA, l_reg, pa0, pa1, pa2, pa3); SBAR();
  pv_d0(o, vb0, pa0, pa1, pa2, pa3); partialSM(pB0, pB1, m_reg, mnB, alB);
  __syncthreads(); RESC(alB);
  finishSM(pB0, pB1, alB, l_reg, pa0, pa1, pa2, pa3); SBAR();
  pv_d0(o, vb0 + (int)SHM_V, pa0, pa1, pa2, pa3);
  if (hi == 0) li_l[r32] = l_reg; asm volatile("s_waitcnt lgkmcnt(0)" ::: "memory");
  float rli[16];
#pragma unroll
  for (int r = 0; r < 16; ++r) rli[r] = __builtin_amdgcn_rcpf(li_l[crow(r, hi)]);
  bf16* Ow = Ob + (int)(wid * QBLK) * LDO;
#pragma unroll
  for (int r = 0; r < 16; ++r) { int orow = crow(r, hi);
    for (int d0 = 0; d0 < 4; ++d0) Ow[(int)orow * LDO + d0 * 32 + r32] = f2bf_att(o[d0][r] * rli[r]); }
#undef SLOAD
#undef SWRITE
#undef SWAIT
#undef RESC
}

}

#define DEV __device__ __forceinline__
typedef unsigned short bf16_t;
typedef float f32x4 __attribute__((ext_vector_type(4)));
typedef float f32x2 __attribute__((ext_vector_type(2)));
typedef float f32x16 __attribute__((ext_vector_type(16)));
typedef short bf16x8 __attribute__((ext_vector_type(8)));
typedef unsigned u32x2 __attribute__((ext_vector_type(2)));
typedef unsigned u32x4 __attribute__((ext_vector_type(4)));

constexpr int MROWS = 9216, TPB = 2304;
constexpr int LD_ZA = 1536, LD_ZF = 4608;
constexpr int ZF_ML = 1792, ZF_MLG = 3840, ZF_S5 = 4096;
constexpr int FFN = 5632;
constexpr size_t SZ_RW = (size_t)MROWS * 512;
constexpr size_t W_WIN = 0, W_WG = W_WIN + 6144ull * 2048 * 2, W_BA = W_WG + 8192ull * 2048 * 2, W_BR = W_BA + 2048ull * 1024 * 2, W_BM = W_BR + 2048ull * 512 * 2,
                 W_BS = W_BM + 2048ull * 512 * 2, W_WO = W_BS + 2048ull * 512 * 2, W_FI = W_WO + 2048ull * 2048 * 2, W_FO = W_FI + 11264ull * 2048 * 2,
                 W_GL = W_FO + 2048ull * 5632 * 2, W_END = W_GL + 1024ull * 512 * 2;
constexpr size_t OFF_W = 0;
constexpr size_t OFF_X = OFF_W + W_END;
constexpr size_t OFF_H = OFF_X + (size_t)MROWS * 2048 * 4;
constexpr size_t OFF_ZA = OFF_H + (size_t)MROWS * 2048 * 2;
constexpr size_t OFF_ZF = OFF_ZA + (size_t)MROWS * 1536 * 2;
constexpr size_t OFF_O = OFF_ZF + (size_t)MROWS * 4608 * 4;
constexpr size_t OFF_RW = OFF_O + (size_t)MROWS * 1024 * 2;
constexpr size_t OFF_C12 = OFF_RW + 10 * SZ_RW * 4;
constexpr size_t OFF_SC = OFF_C12 + 2ull * MROWS * 16 * 4;
constexpr size_t OFF_AB = OFF_SC + 6 * SZ_RW * 4;
constexpr size_t OFF_MOD = OFF_AB + 4 * SZ_RW * 2;
constexpr size_t OFF_ABAR = OFF_MOD + 2ull * 5 * 12288 * 4;
constexpr size_t OFF_BBAR = OFF_ABAR + 8192ull * 2 * 4;
constexpr size_t WS_END = OFF_BBAR + 8192ull * 32 * 4;
constexpr size_t OFF_G = OFF_RW;
constexpr size_t OFF_YF = OFF_ZF;
constexpr size_t OFF_Y = OFF_ZF + (size_t)MROWS * 2048 * 4;
constexpr size_t OFF_ACT = OFF_ZF;
static_assert((size_t)MROWS * 8192 * 2 <= 10 * SZ_RW * 4, "G overlay");
static_assert((size_t)MROWS * 2048 * 6 <= (size_t)MROWS * 4608 * 4 && (size_t)MROWS * 5632 * 2 <= (size_t)MROWS * 4608 * 4, "ZF overlays");

struct KP { const float* in[44]; float* out; unsigned char* ws; };


DEV int opaque0() { int z; asm volatile("s_mov_b32 %0, 0" : "=s"(z)); return z; }
DEV float wsum(float v) {
#pragma unroll
    for (int o = 32; o > 0; o >>= 1) v += __shfl_xor(v, o);
    return v;
}
DEV float sigm(float x) { return 1.f / (1.f + __expf(-x)); }
DEV float siluf(float x) { return x / (1.f + __expf(-x)); }
typedef __bf16 bf16x2_t __attribute__((ext_vector_type(2)));
DEV unsigned pk2(float lo, float hi) { f32x2 f = {lo, hi}; bf16x2_t r = __builtin_convertvector(f, bf16x2_t); return __builtin_bit_cast(unsigned, r); }
DEV bf16_t f2bf(float f) { unsigned u = __float_as_uint(f); u += 0x7FFFu + ((u >> 16) & 1u); return (bf16_t)(u >> 16); }
DEV float bf2f(bf16_t b) { return __uint_as_float(((unsigned)b) << 16); }
DEV void lds_wait() { asm volatile("s_waitcnt lgkmcnt(0)" ::: "memory"); }
DEV int seqpos(int s, int d) { return d == 0 ? s : (s < 256 ? 255 - s : 2559 - s); }
DEV int crow16(int r, int hi) { return (r & 3) + 8 * (r >> 2) + 4 * hi; }

struct EpiWin {
    static constexpr bool PERM = false, AFTER_DRAIN = false;
    bf16_t* ZA; float* ZF;
    DEV void operator()(const pg8::f32x4 (&acc)[2][2][4][2], const pg8::Unit& u, int wr, int wc, int fr, int fq) const {
        const int row0 = u.pm * 256 + wr * 64 + fr, col0 = u.pn * 256 + wc * 32 + 4 * fq;
#pragma unroll
        for (int ai = 0; ai < 2; ++ai)
#pragma unroll
            for (int m = 0; m < 4; ++m) { const size_t row = row0 + ai * 128 + m * 16;
#pragma unroll
                for (int bj = 0; bj < 2; ++bj)
#pragma unroll
                    for (int n = 0; n < 2; ++n) { const int col = col0 + bj * 128 + n * 16; const pg8::f32x4 v = acc[ai][bj][m][n];
                        if (u.pn < 6) { u32x2 o; o.x = pk2(v[0], v[1]); o.y = pk2(v[2], v[3]); *(u32x2*)(ZA + row * LD_ZA + col) = o; }
                        else *(pg8::f32x4*)(ZF + row * LD_ZF + (col - 1536)) = v; } }
    }
};
struct EpiGate {
    static constexpr bool PERM = false, AFTER_DRAIN = false;
    bf16_t* G; const float* bg;
    DEV void operator()(const pg8::f32x4 (&acc)[2][2][4][2], const pg8::Unit& u, int wr, int wc, int fr, int fq) const {
        const int row0 = u.pm * 256 + wr * 64 + fr, col0 = u.pn * 256 + wc * 32 + 4 * fq;
        f32x4 bv[2][2];
#pragma unroll
        for (int bj = 0; bj < 2; ++bj)
#pragma unroll
            for (int n = 0; n < 2; ++n) bv[bj][n] = *(const f32x4*)(bg + col0 + bj * 128 + n * 16);
#pragma unroll
        for (int ai = 0; ai < 2; ++ai)
#pragma unroll
            for (int m = 0; m < 4; ++m) { const size_t row = row0 + ai * 128 + m * 16;
#pragma unroll
                for (int bj = 0; bj < 2; ++bj)
#pragma unroll
                    for (int n = 0; n < 2; ++n) { const int col = col0 + bj * 128 + n * 16; const pg8::f32x4 v = acc[ai][bj][m][n]; const f32x4 b = bv[bj][n];
                        u32x2 o; o.x = pk2(sigm(v[0] + b[0]), sigm(v[1] + b[1])); o.y = pk2(sigm(v[2] + b[2]), sigm(v[3] + b[3])); *(u32x2*)(G + row * 8192 + col) = o; } }
    }
};
template <int ACT> struct EpiGlu2 {
    static constexpr bool PERM = false, AFTER_DRAIN = false;
    bf16_t* O; int ldo;
    DEV void operator()(const pg8::f32x4 (&acc)[2][2][4][2], const pg8::Unit& u, int wr, int wc, int fr, int fq) const {
        const int row0 = u.pm * 256 + wr * 64 + fr, col0 = u.pn * 128 + wc * 32 + 4 * fq;
#pragma unroll
        for (int ai = 0; ai < 2; ++ai)
#pragma unroll
            for (int m = 0; m < 4; ++m) { const size_t row = row0 + ai * 128 + m * 16;
#pragma unroll
                for (int n = 0; n < 2; ++n) { const pg8::f32x4 a = acc[ai][0][m][n], b = acc[ai][1][m][n]; float r[4];
#pragma unroll
                    for (int i = 0; i < 4; ++i) r[i] = ACT == 0 ? a[i] * sigm(b[i]) : siluf(a[i]) * b[i];
                    u32x2 o; o.x = pk2(r[0], r[1]); o.y = pk2(r[2], r[3]); *(u32x2*)(O + row * ldo + col0 + n * 16) = o; } }
    }
};
struct EpiMerge {
    static constexpr bool PERM = false, AFTER_DRAIN = false;
    float* Yf; bf16_t* Y; const bf16_t* G; int br, mode;
    DEV void operator()(const pg8::f32x4 (&acc)[2][2][4][2], const pg8::Unit& u, int wr, int wc, int fr, int fq) const {
        const int row0 = u.pm * 256 + wr * 64 + fr, col0 = u.pn * 256 + wc * 32 + 4 * fq;
#pragma unroll
        for (int ai = 0; ai < 2; ++ai)
#pragma unroll
            for (int m = 0; m < 4; ++m) { const size_t row = row0 + ai * 128 + m * 16;
#pragma unroll
                for (int bj = 0; bj < 2; ++bj)
#pragma unroll
                    for (int n = 0; n < 2; ++n) { const int col = col0 + bj * 128 + n * 16; const pg8::f32x4 v = acc[ai][bj][m][n];
                        const u32x2 gg = *(const u32x2*)(G + row * 8192 + br * 2048 + col);
                        f32x4 r; r[0] = v[0] * __uint_as_float(gg.x << 16); r[1] = v[1] * __uint_as_float(gg.x & 0xffff0000u); r[2] = v[2] * __uint_as_float(gg.y << 16); r[3] = v[3] * __uint_as_float(gg.y & 0xffff0000u);
                        float* yp = Yf + row * 2048 + col;
                        if (mode != 0) r += *(const f32x4*)yp;
                        if (mode != 2) *(f32x4*)yp = r;
                        else { u32x2 o; o.x = pk2(r[0], r[1]); o.y = pk2(r[2], r[3]); *(u32x2*)(Y + row * 2048 + col) = o; } } }
    }
};
struct EpiResid {
    static constexpr bool PERM = false, AFTER_DRAIN = false;
    float* X; const float* mod;
    DEV void operator()(const pg8::f32x4 (&acc)[2][2][4][2], const pg8::Unit& u, int wr, int wc, int fr, int fq) const {
        const int row0 = u.pm * 256 + wr * 64 + fr, col0 = u.pn * 256 + wc * 32 + 4 * fq;
        const int b = u.pm / 9, mr = (u.pm - b * 9) == 0 ? 4 : b;
        const float* mp = mod + (size_t)mr * 12288;
        f32x4 gv[2][2];
#pragma unroll
        for (int bj = 0; bj < 2; ++bj)
#pragma unroll
            for (int n = 0; n < 2; ++n) gv[bj][n] = *(const f32x4*)(mp + col0 + bj * 128 + n * 16);
#pragma unroll
        for (int ai = 0; ai < 2; ++ai)
#pragma unroll
            for (int m = 0; m < 4; ++m) { const size_t row = row0 + ai * 128 + m * 16;
#pragma unroll
                for (int bj = 0; bj < 2; ++bj)
#pragma unroll
                    for (int n = 0; n < 2; ++n) { float* xp = X + row * 2048 + col0 + bj * 128 + n * 16; const pg8::f32x4 v = acc[ai][bj][m][n]; f32x4 x = *(const f32x4*)xp;
                        x += gv[bj][n] * (f32x4){v[0], v[1], v[2], v[3]}; *(f32x4*)xp = x; } }
    }
};
template <class Epi> DEV void run_gemm(const bf16_t* A, const bf16_t* Bt, int N, int K, int skip, const Epi& E) {
    pg8::Order S; S.init(skip ? 32 : 36, N, (int)gridDim.x, obid(), skip);
    pg8::Gemm g{A, Bt, MROWS, N, K};
    pg8::gemm_phase<Epi, pg8::Order, false>((PG8_LAS unsigned char*)shm, g, S, E, nullptr);
}

DEV int mapcol(int mode, int n) {
    if (mode == 0) return n;
    if (mode == 1) return n < 5392 ? n : (n < 5632 ? -1 : n - 240);
    if (mode == 2) return 5904 + n;
    const int t = n >> 8, w = n & 255, half = w >> 7, j = w & 127;
    return half * (mode == 3 ? FFN : 512) + t * 128 + j;
}
DEV void tr_item(const float* W, int Nsrc, int K, bf16_t* WT, int nblk, int mode, int item, float* scr, int lane) {
    const int kb = item / nblk, nb = item - kb * nblk, k0 = 64 * kb, n0 = 32 * nb;
    const int src = mapcol(mode, n0 + (lane & 31));
#pragma unroll 8
    for (int i = 0; i < 32; ++i) { const int kk = 2 * i + (lane >> 5); scr[kk * 33 + (lane & 31)] = src >= 0 ? W[(size_t)(k0 + kk) * Nsrc + src] : 0.f; }
    lds_wait();
    const int c = lane & 7;
#pragma unroll
    for (int j = 0; j < 4; ++j) { const int n = (lane >> 3) + 8 * j; const float* s = scr + (8 * c) * 33 + n;
        u32x4 o; o.x = pk2(s[0 * 33], s[1 * 33]); o.y = pk2(s[2 * 33], s[3 * 33]); o.z = pk2(s[4 * 33], s[5 * 33]); o.w = pk2(s[6 * 33], s[7 * 33]);
        *(u32x4*)(WT + (size_t)(n0 + n) * K + k0 + 8 * c) = o; }
    lds_wait();
}
DEV void phase_convert(const KP& p, int l) {
    const int oz = opaque0();
    const int tid = otid(), wave = __builtin_amdgcn_readfirstlane(tid >> 6), lane = tid & 63;
    float* scr = (float*)shm + wave * (64 * 33);
    unsigned char* WB = p.ws + OFF_W;
    const int gw = obid() * 8 + wave, NGW = gridDim.x * 8;
    constexpr int I_WIN = 32 * (6144 / 32), I_WG = 32 * (8192 / 32), I_BA = 16 * 64, I_B5 = 8 * 64, I_WO = 32 * 64, I_FI = 32 * (11264 / 32), I_FO = 88 * 64, I_GL = 8 * 32;
    constexpr int NIT = I_WIN + I_WG + I_BA + 3 * I_B5 + I_WO + I_FI + I_FO + I_GL;
    for (int it = gw; it < NIT; it += NGW) {
        int r = it;
        if (r < I_WIN) { tr_item(p.in[oz + 8] + (size_t)l * 2048 * 14096, 14096, 2048, (bf16_t*)(WB + W_WIN), 6144 / 32, 1, r, scr, lane); continue; } r -= I_WIN;
        if (r < I_WG)  { tr_item(p.in[oz + 8] + (size_t)l * 2048 * 14096, 14096, 2048, (bf16_t*)(WB + W_WG), 8192 / 32, 2, r, scr, lane); continue; } r -= I_WG;
        if (r < I_BA)  { tr_item(p.in[oz + 36] + (size_t)l * 1024 * 2048, 2048, 1024, (bf16_t*)(WB + W_BA), 64, 0, r, scr, lane); continue; } r -= I_BA;
        if (r < I_B5)  { tr_item(p.in[oz + 37] + (size_t)l * 512 * 2048, 2048, 512, (bf16_t*)(WB + W_BR), 64, 0, r, scr, lane); continue; } r -= I_B5;
        if (r < I_B5)  { tr_item(p.in[oz + 38] + (size_t)l * 512 * 2048, 2048, 512, (bf16_t*)(WB + W_BM), 64, 0, r, scr, lane); continue; } r -= I_B5;
        if (r < I_B5)  { tr_item(p.in[oz + 39] + (size_t)l * 512 * 2048, 2048, 512, (bf16_t*)(WB + W_BS), 64, 0, r, scr, lane); continue; } r -= I_B5;
        if (r < I_WO)  { tr_item(p.in[oz + 40] + (size_t)l * 2048 * 2048, 2048, 2048, (bf16_t*)(WB + W_WO), 64, 0, r, scr, lane); continue; } r -= I_WO;
        if (r < I_FI)  { tr_item(p.in[oz + 41] + (size_t)l * 2048 * 11264, 11264, 2048, (bf16_t*)(WB + W_FI), 11264 / 32, 3, r, scr, lane); continue; } r -= I_FI;
        if (r < I_FO)  { tr_item(p.in[oz + 42] + (size_t)l * 5632 * 2048, 2048, 5632, (bf16_t*)(WB + W_FO), 64, 0, r, scr, lane); continue; } r -= I_FO;
        tr_item(p.in[oz + 35] + (size_t)l * 512 * 1024, 1024, 512, (bf16_t*)(WB + W_GL), 32, 4, r, scr, lane);
    }
}
DEV void phase_mod(const KP& p) {
    const int oz = opaque0();
    const int tid = otid(), wave = __builtin_amdgcn_readfirstlane(tid >> 6), lane = tid & 63;
    float* sc = (float*)shm; float* red = sc + 5 * 2048;
    __syncthreads();
    for (int i = tid; i < 5 * 2048; i += 512) { const int r = i >> 11, k = i & 2047; const float c = r < 4 ? p.in[oz + 1][r * 2048 + k] : p.in[oz + 3][k]; sc[i] = siluf(c); }
    __syncthreads();
    float* MOD = (float*)(p.ws + OFF_MOD);
    for (int it = obid(); it < 384; it += gridDim.x) {
        const int l = it / 192, cb = it - l * 192, col = cb * 64 + lane;
        const float* W = p.in[oz + 4] + (size_t)l * 2048 * 12288 + col;
        float a0 = 0.f, a1 = 0.f, a2 = 0.f, a3 = 0.f, a4 = 0.f;
#pragma unroll 8
        for (int k = wave * 256; k < wave * 256 + 256; ++k) { const float wv = W[(size_t)k * 12288];
            a0 += sc[k] * wv; a1 += sc[2048 + k] * wv; a2 += sc[4096 + k] * wv; a3 += sc[6144 + k] * wv; a4 += sc[8192 + k] * wv; }
        red[(wave * 5 + 0) * 64 + lane] = a0; red[(wave * 5 + 1) * 64 + lane] = a1; red[(wave * 5 + 2) * 64 + lane] = a2; red[(wave * 5 + 3) * 64 + lane] = a3; red[(wave * 5 + 4) * 64 + lane] = a4;
        __syncthreads();
        if (tid < 320) { const int r = tid >> 6; float s = 0.f;
#pragma unroll
            for (int w = 0; w < 8; ++w) s += red[(w * 5 + r) * 64 + lane];
            MOD[(size_t)(l * 5 + r) * 12288 + col] = s + p.in[oz + 5][l * 12288 + col]; }
        __syncthreads();
    }
}
DEV void phase_s5disc(const KP& p) {
    const int oz = opaque0();
    float* ABAR = (float*)(p.ws + OFF_ABAR); float* BBAR = (float*)(p.ws + OFF_BBAR);
    for (int gid = obid() * 512 + otid(); gid < 8192; gid += gridDim.x * 512) {
        const int ldg = gid >> 6;
        const float lre = p.in[oz + 27][gid], lim = p.in[oz + 28][gid], dt = expf(p.in[oz + 29][ldg]);
        const float mag = expf(lre * dt), ang = lim * dt, ar = mag * cosf(ang), ai = mag * sinf(ang);
        const float den = lre * lre + lim * lim;
        const float fr = ((ar - 1.f) * lre + ai * lim) / den, fi = (ai * lre - (ar - 1.f) * lim) / den;
        ABAR[gid * 2] = ar; ABAR[gid * 2 + 1] = ai;
#pragma unroll 4
        for (int c = 0; c < 16; ++c) { const float br = p.in[oz + 30][gid * 16 + c], bi = p.in[oz + 31][gid * 16 + c];
            BBAR[(gid * 16 + c) * 2] = fr * br - fi * bi; BBAR[(gid * 16 + c) * 2 + 1] = fr * bi + fi * br; }
    }
}
DEV void phase_norm(const KP& p, int l, int which, bool from_input, bool skipctx) {
    const int oz = opaque0();
    const int tid = otid(), wave = __builtin_amdgcn_readfirstlane(tid >> 6), lane = tid & 63;
    const int gw = obid() * 8 + wave, NGW = gridDim.x * 8;
    float* X = (float*)(p.ws + OFF_X); bf16_t* H = (bf16_t*)(p.ws + OFF_H);
    const float* MOD = (const float*)(p.ws + OFF_MOD);
    const float* gam = p.in[oz + (which ? 7 : 6)] + l * 2048;
    for (int row = gw; row < MROWS; row += NGW) {
        const int b = row / TPB, pp = row - b * TPB, mr = pp < 256 ? 4 : b;
        if (skipctx && pp < 256) continue;
        const float* src = from_input ? (pp < 256 ? p.in[oz + 2] + ((size_t)b * 256 + pp) * 2048 : p.in[oz + 0] + ((size_t)b * 2048 + (pp - 256)) * 2048) : X + (size_t)row * 2048;
        f32x4 v[8]; float ss = 0.f;
#pragma unroll
        for (int j = 0; j < 8; ++j) { v[j] = ((const f32x4*)src)[lane + 64 * j]; ss += v[j][0] * v[j][0] + v[j][1] * v[j][1] + v[j][2] * v[j][2] + v[j][3] * v[j][3]; }
        ss = wsum(ss);
        const float rs = 1.f / sqrtf(ss * (1.f / 2048.f) + 1e-6f);
        const float* shp = MOD + (size_t)(l * 5 + mr) * 12288 + (which ? 3 : 0) * 2048; const float* scp = shp + 2048;
#pragma unroll
        for (int j = 0; j < 8; ++j) { const int c4 = lane + 64 * j;
            if (from_input) ((f32x4*)(X + (size_t)row * 2048))[c4] = v[j];
            const f32x4 g = ((const f32x4*)gam)[c4], sh = ((const f32x4*)shp)[c4], sc = ((const f32x4*)scp)[c4];
            const f32x4 y = v[j] * rs * g; const f32x4 h = y * (sc + 1.f) + sh;
            u32x2 o; o.x = pk2(h[0], h[1]); o.y = pk2(h[2], h[3]); ((u32x2*)(H + (size_t)row * 2048))[c4] = o; }
    }
}
DEV void phase_final(const KP& p) {
    const int oz = opaque0();
    const int tid = otid(), wave = __builtin_amdgcn_readfirstlane(tid >> 6), lane = tid & 63;
    const int gw = obid() * 8 + wave, NGW = gridDim.x * 8;
    const float* X = (const float*)(p.ws + OFF_X); const float* gam = p.in[oz + 43];
    for (int r = gw; r < 8192; r += NGW) {
        const int b = r >> 11, t = r & 2047; const float* src = X + ((size_t)b * TPB + 256 + t) * 2048;
        f32x4 v[8]; float ss = 0.f;
#pragma unroll
        for (int j = 0; j < 8; ++j) { v[j] = ((const f32x4*)src)[lane + 64 * j]; ss += v[j][0] * v[j][0] + v[j][1] * v[j][1] + v[j][2] * v[j][2] + v[j][3] * v[j][3]; }
        ss = wsum(ss);
        const float rs = 1.f / sqrtf(ss * (1.f / 2048.f) + 1e-6f);
#pragma unroll
        for (int j = 0; j < 8; ++j) { const int c4 = lane + 64 * j; ((f32x4*)(p.out + (size_t)r * 2048))[c4] = v[j] * rs * ((const f32x4*)gam)[c4]; }
    }
}
DEV void phase_attnprep(const KP& p, int l) {
    const int oz = opaque0();
    const int tid = otid(), wave = __builtin_amdgcn_readfirstlane(tid >> 6), lane = tid & 63;
    const int gw = obid() * 8 + wave, NGW = gridDim.x * 8;
    bf16_t* ZA = (bf16_t*)(p.ws + OFF_ZA);
    const float* qg = p.in[oz + 10] + l * 128; const float* kg = p.in[oz + 11] + l * 128;
    const float qg0 = qg[lane], qg1 = qg[64 + lane], kg0 = kg[lane], kg1 = kg[64 + lane];
    const float invf = exp2f(-(float)(lane & 31) * (13.287712379549449f / 32.f));
    for (int row = gw; row < MROWS; row += NGW) {
        bf16_t* z = ZA + (size_t)row * LD_ZA; const int pp = row % TPB; const bool lat = pp >= 256; const int t = pp - 256;
        float cr = 1.f, sr = 0.f, cc = 1.f, scn = 0.f;
        if (lat) { const float a1 = (float)(t >> 6) * invf, a2 = (float)(t & 63) * invf; cr = __cosf(a1); sr = __sinf(a1); cc = __cosf(a2); scn = __sinf(a2); }
#pragma unroll 2
        for (int j = 0; j < 10; ++j) {
            const float v0 = bf2f(z[j * 128 + lane]), v1 = bf2f(z[j * 128 + 64 + lane]);
            const float ss = wsum(v0 * v0 + v1 * v1); const float rs = 1.f / sqrtf(ss * (1.f / 128.f) + 1e-6f);
            float y0 = v0 * rs * (j < 8 ? qg0 : kg0), y1 = v1 * rs * (j < 8 ? qg1 : kg1);
            if (lat) { const float p0 = __shfl_xor(y0, 32), p1 = __shfl_xor(y1, 32);
                if (lane < 32) { y0 = y0 * cr - p0 * sr; y1 = y1 * cc - p1 * scn; } else { y0 = p0 * sr + y0 * cr; y1 = p1 * scn + y1 * cc; } }
            z[j * 128 + lane] = f2bf(y0); z[j * 128 + 64 + lane] = f2bf(y1);
        }
    }
}
DEV float shiftz(const float* ZF, int row, int col, float mu) {
    const int pp = row % TPB; const float* zp = ZF + (size_t)row * LD_ZF + col; const float z = zp[0];
    const float zl = (pp != 0 && pp != 256) ? zp[-LD_ZF] : 0.f, zr = (pp != 255 && pp != 2303) ? zp[LD_ZF] : 0.f;
    return z + mu * (0.5f * (zl + zr) - z);
}
DEV void phase_rwkvprep(const KP& p, int l) {
    const int oz = opaque0();
    const int tid = otid(), wave = __builtin_amdgcn_readfirstlane(tid >> 6), lane = tid & 63, j = tid;
    float* lin = (float*)shm;
    const float* ZF = (const float*)(p.ws + OFF_ZF);
    float* RW = (float*)(p.ws + OFF_RW); float* C12 = (float*)(p.ws + OFF_C12);
    const float* mu = p.in[oz + 12] + l * 1792;
    const float w00 = p.in[oz + 13][(l * 2 + 0) * 512 + j], w01 = p.in[oz + 13][(l * 2 + 1) * 512 + j], a00 = p.in[oz + 15][(l * 2 + 0) * 512 + j], a01 = p.in[oz + 15][(l * 2 + 1) * 512 + j];
    const float kkc = p.in[oz + 18][l * 512 + j], kac = p.in[oz + 19][l * 512 + j], rkc = p.in[oz + 20][l * 512 + j], mu_r = mu[j], mu_k = mu[512 + j], mu_v = mu[1024 + j];
    const float* wup0 = p.in[oz + 14] + (size_t)((l * 2 + 0) * 64) * 512 + j; const float* wup1 = p.in[oz + 14] + (size_t)((l * 2 + 1) * 64) * 512 + j;
    const float* aup0 = p.in[oz + 16] + (size_t)((l * 2 + 0) * 64) * 512 + j; const float* aup1 = p.in[oz + 16] + (size_t)((l * 2 + 1) * 64) * 512 + j;
    const float* gup = p.in[oz + 17] + (size_t)(l * 128) * 512 + j;
    for (int it = obid(); it < 768; it += gridDim.x) {
        const int row0 = it * 12;
        __syncthreads();
        for (int e = tid; e < 12 * 256; e += 512) { const int t = e >> 8, cc = e & 255; const float z = shiftz(ZF, row0 + t, 1536 + cc, mu[1536 + cc]);
            lin[e] = cc < 64 ? tanhf(z) : (cc < 128 ? z : sigm(z)); }
        __syncthreads();
        float aw0[12], aw1[12], aa0[12], aa1[12], ag[12];
#pragma unroll
        for (int t = 0; t < 12; ++t) { aw0[t] = 0.f; aw1[t] = 0.f; aa0[t] = 0.f; aa1[t] = 0.f; ag[t] = 0.f; }
#pragma unroll 1
        for (int k = 0; k < 64; k += 4) {
            float u0[4], u1[4], v0[4], v1[4];
#pragma unroll
            for (int i = 0; i < 4; ++i) { u0[i] = wup0[(k + i) * 512]; u1[i] = wup1[(k + i) * 512]; v0[i] = aup0[(k + i) * 512]; v1[i] = aup1[(k + i) * 512]; }
#pragma unroll
            for (int t = 0; t < 12; ++t) { const f32x4 lw = *(const f32x4*)(lin + t * 256 + k), la = *(const f32x4*)(lin + t * 256 + 64 + k);
#pragma unroll
                for (int i = 0; i < 4; ++i) { aw0[t] += lw[i] * u0[i]; aw1[t] += lw[i] * u1[i]; aa0[t] += la[i] * v0[i]; aa1[t] += la[i] * v1[i]; } }
        }
#pragma unroll 1
        for (int k = 0; k < 128; k += 4) {
            float u0[4];
#pragma unroll
            for (int i = 0; i < 4; ++i) u0[i] = gup[(k + i) * 512];
#pragma unroll
            for (int t = 0; t < 12; ++t) { const f32x4 lg = *(const f32x4*)(lin + t * 256 + 128 + k);
#pragma unroll
                for (int i = 0; i < 4; ++i) ag[t] += lg[i] * u0[i]; }
        }
#pragma unroll
        for (int t = 0; t < 12; ++t) {
            const int row = row0 + t; const size_t o = (size_t)row * 512 + j;
            const float r = shiftz(ZF, row, j, mu_r), k = shiftz(ZF, row, 512 + j, mu_k), v = shiftz(ZF, row, 1024 + j, mu_v);
            const float kkr = k * kkc; const float ss = wsum(kkr * kkr); const float kk = kkr * (1.f / sqrtf(ss + 1e-12f));
            RW[0 * SZ_RW + o] = r; RW[1 * SZ_RW + o] = v; RW[2 * SZ_RW + o] = kk; RW[9 * SZ_RW + o] = ag[t];
#pragma unroll
            for (int d = 0; d < 2; ++d) {
                const float wpre = (d ? w01 : w00) + (d ? aw1[t] : aw0[t]);
                const float w = __expf(-0.6065306597126334f * sigm(wpre));
                const float a = sigm((d ? a01 : a00) + (d ? aa1[t] : aa0[t]));
                const float km = k * (1.f + (a - 1.f) * kac), bb = a * kk;
                const float c1 = wsum(bb * r), c2 = wsum(r * km * (1.f + rkc));
                RW[(3 + d) * SZ_RW + o] = w; RW[(5 + d) * SZ_RW + o] = bb; RW[(7 + d) * SZ_RW + o] = km;
                if (lane == 0) { float* cp = C12 + (((size_t)d * MROWS + row) * 8 + wave) * 2; cp[0] = c1; cp[1] = c2; }
            }
        }
    }
}

DEV void rwkv_scan(const KP& p, int sid) {
    const int oz = opaque0();
    const int b = sid >> 4, h = (sid >> 1) & 7, d = sid & 1;
    const int tid = otid(), wave = __builtin_amdgcn_readfirstlane(tid >> 6), lane = tid & 63, rr = lane >> 3, kg = lane & 7;
    float* buf = (float*)shm;
    float* olds = buf + 16 * 400;
    const float* RW = (const float*)(p.ws + OFF_RW);
    const float* C12 = (const float*)(p.ws + OFF_C12) + (size_t)d * MROWS * 16;
    float* ORW = (float*)(p.ws + OFF_SC) + (size_t)d * SZ_RW;
    const int lstep = tid >> 5, lq = tid & 31;
    float S[8];
#pragma unroll
    for (int i = 0; i < 8; ++i) S[i] = 0.f;
    f32x4 st0, st1, st2; f32x2 cst = {0.f, 0.f};
#define RWK_SRC(e_, row_) (RW + (size_t)((((e_) >> 4) == 0) ? 3 + d : (((e_) >> 4) == 1) ? 2 : (((e_) >> 4) == 2) ? 5 + d : (((e_) >> 4) == 3) ? 7 + d : (((e_) >> 4) == 4) ? 0 : 1) * SZ_RW + (size_t)(row_) * 512 + h * 64 + ((e_) & 15) * 4)
#define RWK_ISSUE(chunk_) do { const int row_ = b * TPB + seqpos((chunk_) * 16 + lstep, d); \
        st0 = *(const f32x4*)RWK_SRC(lq, row_); st1 = *(const f32x4*)RWK_SRC(lq + 32, row_); st2 = *(const f32x4*)RWK_SRC(lq + 64, row_); \
        if (lq == 0) cst = *(const f32x2*)(C12 + ((size_t)row_ * 8 + h) * 2); } while (0)
#define RWK_COMMIT() do { float* bp_ = buf + lstep * 400; *(f32x4*)(bp_ + lq * 4) = st0; *(f32x4*)(bp_ + (lq + 32) * 4) = st1; *(f32x4*)(bp_ + (lq + 64) * 4) = st2; \
        if (lq == 0) { bp_[384] = cst[0]; bp_[385] = cst[1]; } } while (0)
    __syncthreads();
    RWK_ISSUE(0); RWK_COMMIT();
    __syncthreads();
#pragma unroll 1
    for (int c = 0; c < 144; ++c) {
        if (c + 1 < 144) RWK_ISSUE(c + 1);
#pragma unroll 2
        for (int step = 0; step < 16; ++step) {
            const float* sp = buf + step * 400 + kg * 8;
            const f32x4 w0 = *(const f32x4*)(sp), w1 = *(const f32x4*)(sp + 4), k0 = *(const f32x4*)(sp + 64), k1 = *(const f32x4*)(sp + 68);
            const f32x4 b0 = *(const f32x4*)(sp + 128), b1 = *(const f32x4*)(sp + 132), m0 = *(const f32x4*)(sp + 192), m1 = *(const f32x4*)(sp + 196);
            const f32x4 r0 = *(const f32x4*)(sp + 256), r1 = *(const f32x4*)(sp + 260);
            const float* sq = buf + step * 400;
            const float vv = sq[320 + wave * 8 + rr], c1 = sq[384], c2 = sq[385];
            float sa = 0.f, so = 0.f;
#pragma unroll
            for (int i = 0; i < 4; ++i) { sa += S[i] * k0[i]; so += S[i] * (w0[i] * r0[i]); }
#pragma unroll
            for (int i = 0; i < 4; ++i) { sa += S[4 + i] * k1[i]; so += S[4 + i] * (w1[i] * r1[i]); }
            sa += __shfl_xor(sa, 1); so += __shfl_xor(so, 1);
            sa += __shfl_xor(sa, 2); so += __shfl_xor(so, 2);
            sa += __shfl_xor(sa, 4); so += __shfl_xor(so, 4);
#pragma unroll
            for (int i = 0; i < 4; ++i) { S[i] = S[i] * w0[i] + (vv * m0[i] - sa * b0[i]); S[4 + i] = S[4 + i] * w1[i] + (vv * m1[i] - sa * b1[i]); }
            if (kg == 0) olds[step * 64 + wave * 8 + rr] = so - sa * c1 + vv * c2;
        }
        __syncthreads();
        { const int row_ = b * TPB + seqpos(c * 16 + lstep, d); *(f32x2*)(ORW + (size_t)row_ * 512 + h * 64 + lq * 2) = *(const f32x2*)(olds + lstep * 64 + lq * 2); }
        if (c + 1 < 144) RWK_COMMIT();
        __syncthreads();
    }
#undef RWK_SRC
#undef RWK_ISSUE
#undef RWK_COMMIT
}

DEV f32x16 mfma32(bf16x8 a, bf16x8 b, f32x16 c) { return __builtin_amdgcn_mfma_f32_32x32x16_bf16(a, b, c, 0, 0, 0); }
DEV void mlstm_scan(const KP& p, int l, int mid) {
    const int oz = opaque0();
    const int b = mid >> 4, h = (mid >> 2) & 3, d = (mid >> 1) & 1, vbase = (mid & 1) * 64;
    const int tid = otid(), wave = __builtin_amdgcn_readfirstlane(tid >> 6), lane = tid & 63, r32 = lane & 31, hi = lane >> 5;
    bf16_t* Qc = (bf16_t*)shm;
    bf16_t* Kc = Qc + 64 * 136;
    bf16_t* KcT = Kc + 64 * 136;
    bf16_t* VT = KcT + 128 * 72;
    bf16_t* VsT = VT + 64 * 72;
    bf16_t* Sm = VsT + 64 * 72;
    bf16_t* Cb = Sm + 64 * 72;
    float* fl = (float*)(Cb + 64 * 136);
    float* gS = fl, *MtS = fl + 64, *srcS = fl + 128, *winS = fl + 192, *emtS = fl + 256, *nvec = fl + 320, *rsp = fl + 448, *nqp = fl + 576, *dnw = fl + 1088, *cw = fl + 1344;
    bf16_t* Ql = (bf16_t*)(fl + 2112);
    bf16_t* Kl = Ql + 64 * 136;
    const float* ZF = (const float*)(p.ws + OFF_ZF);
    float* HM = (float*)(p.ws + OFF_SC) + (size_t)(2 + d) * SZ_RW;
    const float ib = p.in[oz + 24][l * 8 + d * 4 + h], fb = p.in[oz + 25][l * 8 + d * 4 + h];
    __syncthreads();
    for (int e = tid; e < 64 * 136; e += 512) Cb[e] = 0;
    if (tid < 128) nvec[tid] = 0.f;
    for (int e = tid; e < 768; e += 512) { const int jj = e >> 8, c = e & 255; cw[e] = p.in[oz + 23][(size_t)(l * 3 + jj) * 1024 + (c < 128 ? h * 128 + c : 512 + h * 128 + (c - 128))]; }
    __syncthreads();
    f32x16 accC;
#pragma unroll
    for (int r = 0; r < 16; ++r) accC[r] = 0.f;
    float m = 0.f;
    const int ti = tid >> 3, cg8 = tid & 7;
#pragma unroll 1
    for (int c = 0; c < 36; ++c) {
        const int rowi = b * TPB + seqpos(64 * c + lane, d);
        const float igv = ZF[(size_t)rowi * LD_ZF + ZF_MLG + d * 4 + h] + ib, fgv = ZF[(size_t)rowi * LD_ZF + ZF_MLG + 8 + d * 4 + h] + fb;
        const float lf = fgv > 0.f ? -log1pf(__expf(-fgv)) : fgv - log1pf(__expf(fgv));
        float cum = lf;
#pragma unroll
        for (int o = 1; o < 64; o <<= 1) { const float t = __shfl_up(cum, o); if (lane >= o) cum += t; }
        const float g = igv - cum; float pm = g;
#pragma unroll
        for (int o = 1; o < 64; o <<= 1) { const float t = __shfl_up(pm, o); if (lane >= o) pm = fmaxf(pm, t); }
        const float Mt = fmaxf(pm, m), M63 = __shfl(Mt, 63), total = __shfl(cum, 63);
        const float src = __expf(g - M63), decay = __expf(m - M63), win = __expf(m - Mt), emt = __expf(-(cum + Mt));
        if (wave == 0) { gS[lane] = g; MtS[lane] = Mt; srcS[lane] = src; winS[lane] = win; emtS[lane] = emt; }
        const float m_next = total + M63;
        {
            const int pT = seqpos(64 * c + ti, d); const size_t rowT = (size_t)b * TPB + pT;
            const bool hasL = (pT != 0 && pT != 256), hasR = (pT != 255 && pT != 2303);
            const float* zc = ZF + rowT * LD_ZF + ZF_ML;
            const float srcT = __shfl(src, ti);
#pragma unroll
            for (int part = 0; part < 2; ++part) {
                const float* base = zc + part * 512 + h * 128 + 16 * cg8;
#pragma unroll
                for (int v4 = 0; v4 < 4; ++v4) {
                    const f32x4 zm = *(const f32x4*)(base + 4 * v4);
                    f32x4 zl = {0.f, 0.f, 0.f, 0.f}, zr = {0.f, 0.f, 0.f, 0.f};
                    if (hasL) zl = *(const f32x4*)(base - LD_ZF + 4 * v4);
                    if (hasR) zr = *(const f32x4*)(base + LD_ZF + 4 * v4);
                    const int cc = part * 128 + 16 * cg8 + 4 * v4;
                    const f32x4 w0 = *(const f32x4*)(cw + cc), w1 = *(const f32x4*)(cw + 256 + cc), w2 = *(const f32x4*)(cw + 512 + cc);
                    f32x4 val = zl * w0 + zm * w1 + zr * w2;
#pragma unroll
                    for (int i = 0; i < 4; ++i) val[i] = siluf(val[i]) * (part ? 0.08838834764831845f : 1.f);
                    u32x2 o; o.x = pk2(val[0], val[1]); o.y = pk2(val[2], val[3]);
                    u32x2 ol; ol.x = pk2(val[0] - __uint_as_float(o.x << 16), val[1] - __uint_as_float(o.x & 0xffff0000u)); ol.y = pk2(val[2] - __uint_as_float(o.y << 16), val[3] - __uint_as_float(o.y & 0xffff0000u));
                    const int ch = 16 * cg8 + 4 * v4;
                    if (part == 0) { *(u32x2*)(Qc + ti * 136 + ch) = o; *(u32x2*)(Ql + ti * 136 + ch) = ol; }
                    else { *(u32x2*)(Kc + ti * 136 + ch) = o; *(u32x2*)(Kl + ti * 136 + ch) = ol;
                        KcT[(ch + 0) * 72 + ti] = (bf16_t)(o.x & 0xffffu); KcT[(ch + 1) * 72 + ti] = (bf16_t)(o.x >> 16); KcT[(ch + 2) * 72 + ti] = (bf16_t)(o.y & 0xffffu); KcT[(ch + 3) * 72 + ti] = (bf16_t)(o.y >> 16); }
                }
            }
            const float* vsrc = zc + 1024 + h * 128 + vbase + 8 * cg8;
#pragma unroll
            for (int v4 = 0; v4 < 2; ++v4) { const f32x4 vv = *(const f32x4*)(vsrc + 4 * v4);
#pragma unroll
                for (int i = 0; i < 4; ++i) { const int vc = 8 * cg8 + 4 * v4 + i; VT[vc * 72 + ti] = f2bf(vv[i]); VsT[vc * 72 + ti] = f2bf(vv[i] * srcT); } }
        }
        __syncthreads();
        f32x16 acc2;
#pragma unroll
        for (int r = 0; r < 16; ++r) acc2[r] = 0.f;
        const int w4 = wave - 4, tt2 = (w4 >> 1) & 1, vt = w4 & 1;
        if (wave < 4) {
            const int st = wave & 1, tt = wave >> 1;
            f32x16 acc;
#pragma unroll
            for (int r = 0; r < 16; ++r) acc[r] = 0.f;
            if (!(st == 1 && tt == 0)) {
#pragma unroll
                for (int kk = 0; kk < 8; ++kk) { const int ao = (32 * st + r32) * 136 + 16 * kk + 8 * hi, bo = (32 * tt + r32) * 136 + 16 * kk + 8 * hi;
                    const bf16x8 a = *(const bf16x8*)(Kc + ao), bq = *(const bf16x8*)(Qc + bo), al = *(const bf16x8*)(Kl + ao), bl = *(const bf16x8*)(Ql + bo);
                    acc = mfma32(al, bq, acc); acc = mfma32(a, bl, acc); acc = mfma32(a, bq, acc); }
            }
            const int t = 32 * tt + r32; const float Mtt = MtS[t]; float psum = 0.f;
#pragma unroll
            for (int r4 = 0; r4 < 4; ++r4) { float vals[4];
#pragma unroll
                for (int i = 0; i < 4; ++i) { const int r = r4 * 4 + i, s = 32 * st + crow16(r, hi); const float dv = (s <= t) ? __expf(gS[s] - Mtt) : 0.f; vals[i] = acc[r] * dv; psum += vals[i]; }
                u32x2 o; o.x = pk2(vals[0], vals[1]); o.y = pk2(vals[2], vals[3]); *(u32x2*)(Sm + t * 72 + 32 * st + 8 * r4 + 4 * hi) = o; }
            psum += __shfl_xor(psum, 32);
            if (hi == 0) rsp[st * 64 + t] = psum;
        } else {
#pragma unroll
            for (int kk = 0; kk < 8; ++kk) { const bf16x8 a = *(const bf16x8*)(Qc + (32 * tt2 + r32) * 136 + 16 * kk + 8 * hi), bb = *(const bf16x8*)(Cb + (32 * vt + r32) * 136 + 16 * kk + 8 * hi);
                acc2 = mfma32(a, bb, acc2); }
        }
        { const int t = tid & 63, part = tid >> 6; float s = 0.f;
#pragma unroll
            for (int k = 0; k < 16; ++k) s += nvec[part * 16 + k] * (bf2f(Qc[t * 136 + part * 16 + k]) + bf2f(Ql[t * 136 + part * 16 + k]));
            nqp[part * 64 + t] = s; }
        __syncthreads();
        if (wave >= 4) {
            float den = rsp[lane] + rsp[64 + lane]; float nq = 0.f;
#pragma unroll
            for (int part = 0; part < 8; ++part) nq += nqp[part * 64 + lane];
            den += winS[lane] * nq;
            float* my = dnw + w4 * 64; my[lane] = 1.f / fmaxf(fabsf(den), emtS[lane]); lds_wait();
#pragma unroll
            for (int r = 0; r < 16; ++r) acc2[r] *= winS[32 * tt2 + crow16(r, hi)];
#pragma unroll
            for (int kk = 0; kk < 4; ++kk) { const bf16x8 a = *(const bf16x8*)(Sm + (32 * tt2 + r32) * 72 + 16 * kk + 8 * hi), bb = *(const bf16x8*)(VT + (32 * vt + r32) * 72 + 16 * kk + 8 * hi);
                acc2 = mfma32(a, bb, acc2); }
#pragma unroll
            for (int r = 0; r < 16; ++r) { const int t = 32 * tt2 + crow16(r, hi); const int pT = seqpos(64 * c + t, d);
                HM[((size_t)b * TPB + pT) * 512 + h * 128 + vbase + 32 * vt + r32] = acc2[r] * my[t]; }
        } else if (wave < 2) {
            float s = 0.f;
#pragma unroll 8
            for (int si = 0; si < 64; ++si) s += srcS[si] * bf2f(KcT[tid * 72 + si]);
            nvec[tid] = decay * nvec[tid] + s;
        }
        { const int kt = wave & 3, vt2 = wave >> 2;
#pragma unroll
            for (int r = 0; r < 16; ++r) accC[r] *= decay;
#pragma unroll
            for (int kk = 0; kk < 4; ++kk) { const bf16x8 a = *(const bf16x8*)(KcT + (32 * kt + r32) * 72 + 16 * kk + 8 * hi), bb = *(const bf16x8*)(VsT + (32 * vt2 + r32) * 72 + 16 * kk + 8 * hi);
                accC = mfma32(a, bb, accC); }
#pragma unroll
            for (int r4 = 0; r4 < 4; ++r4) { u32x2 o; o.x = pk2(accC[r4 * 4 + 0], accC[r4 * 4 + 1]); o.y = pk2(accC[r4 * 4 + 2], accC[r4 * 4 + 3]);
                *(u32x2*)(Cb + (32 * vt2 + r32) * 136 + 32 * kt + 8 * r4 + 4 * hi) = o; } }
        m = m_next;
        __syncthreads();
    }
}

DEV void s5_scan(const KP& p, int l, int sid) {
    const int oz = opaque0();
    const int b = sid >> 6, g = (sid >> 1) & 31, d = sid & 1;
    const int tid = otid(), wave = __builtin_amdgcn_readfirstlane(tid >> 6), lane = tid & 63;
    float* CRs = (float*)shm; float* CIs = CRs + 1024; float* Fs = CIs + 1024;
    float* us = Fs + 1024 + wave * (256 + 2 * 16 * 65); float* xsr = us + 256; float* xsi = xsr + 16 * 65;
    const int ldg = (l * 2 + d) * 32 + g, gid = ldg * 64 + lane;
    const float* ABAR = (const float*)(p.ws + OFF_ABAR); const float* BBAR = (const float*)(p.ws + OFF_BBAR);
    const float* ZF = (const float*)(p.ws + OFF_ZF);
    float* YS = (float*)(p.ws + OFF_SC) + (size_t)(4 + d) * SZ_RW;
    const float ar = ABAR[gid * 2], ai = ABAR[gid * 2 + 1];
    float bbr[16], bbi[16];
#pragma unroll
    for (int c = 0; c < 8; ++c) { const f32x4 t = *(const f32x4*)(BBAR + (size_t)gid * 32 + c * 4); bbr[2 * c] = t[0]; bbi[2 * c] = t[1]; bbr[2 * c + 1] = t[2]; bbi[2 * c + 1] = t[3]; }
    __syncthreads();
    for (int e = tid; e < 1024; e += 512) { const int c = e >> 6, pp = e & 63; CRs[pp * 16 + c] = p.in[oz + 32][(size_t)ldg * 1024 + e]; CIs[pp * 16 + c] = p.in[oz + 33][(size_t)ldg * 1024 + e]; }
    const int s0w = wave * 288, lstep = lane >> 2, lpart = lane & 3;
#define S5_LOADU(sub_) (*(const f32x4*)(ZF + ((size_t)b * TPB + seqpos(s0w + (sub_) * 16 + lstep, d)) * LD_ZF + ZF_S5 + g * 16 + lpart * 4))
#define S5_STEP(step_) do { const f32x4 ua = *(const f32x4*)(us + (step_) * 16), ub = *(const f32x4*)(us + (step_) * 16 + 4), uc = *(const f32x4*)(us + (step_) * 16 + 8), ud = *(const f32x4*)(us + (step_) * 16 + 12); \
        float bur = 0.f, bui = 0.f; \
        _Pragma("unroll") for (int i_ = 0; i_ < 4; ++i_) { bur += bbr[i_] * ua[i_]; bui += bbi[i_] * ua[i_]; } \
        _Pragma("unroll") for (int i_ = 0; i_ < 4; ++i_) { bur += bbr[4 + i_] * ub[i_]; bui += bbi[4 + i_] * ub[i_]; } \
        _Pragma("unroll") for (int i_ = 0; i_ < 4; ++i_) { bur += bbr[8 + i_] * uc[i_]; bui += bbi[8 + i_] * uc[i_]; } \
        _Pragma("unroll") for (int i_ = 0; i_ < 4; ++i_) { bur += bbr[12 + i_] * ud[i_]; bui += bbi[12 + i_] * ud[i_]; } \
        const float nxr_ = ar * xr - ai * xi + bur, nxi_ = ar * xi + ai * xr + bui; xr = nxr_; xi = nxi_; } while (0)
    float xr = 0.f, xi = 0.f;
    f32x4 un = S5_LOADU(0);
#pragma unroll 1
    for (int sub = 0; sub < 18; ++sub) {
        lds_wait(); *(f32x4*)(us + lane * 4) = un; lds_wait();
        if (sub + 1 < 18) un = S5_LOADU(sub + 1);
#pragma unroll 4
        for (int step = 0; step < 16; ++step) S5_STEP(step);
    }
    Fs[(wave * 64 + lane) * 2] = xr; Fs[(wave * 64 + lane) * 2 + 1] = xi;
    __syncthreads();
    { float pr = ar, pi = ai, qr = 0.f, qi = 0.f;
#pragma unroll
        for (int i = 0; i < 8; ++i) { const float nr = pr * pr - pi * pi, ni = 2.f * pr * pi; pr = nr; pi = ni; if (i == 4) { qr = pr; qi = pi; } }
        const float er = pr * qr - pi * qi, ei = pr * qi + pi * qr;
        xr = 0.f; xi = 0.f;
        for (int w = 0; w < wave; ++w) { const float fr = Fs[(w * 64 + lane) * 2], fi = Fs[(w * 64 + lane) * 2 + 1]; const float nr = er * xr - ei * xi + fr, ni = er * xi + ei * xr + fi; xr = nr; xi = ni; } }
    un = S5_LOADU(0);
#pragma unroll 1
    for (int sub = 0; sub < 18; ++sub) {
        lds_wait(); *(f32x4*)(us + lane * 4) = un; lds_wait();
        if (sub + 1 < 18) un = S5_LOADU(sub + 1);
#pragma unroll 4
        for (int step = 0; step < 16; ++step) { S5_STEP(step); xsr[step * 65 + lane] = xr; xsi[step * 65 + lane] = xi; }
        lds_wait();
        f32x4 acc = {0.f, 0.f, 0.f, 0.f};
#pragma unroll 8
        for (int pp = 0; pp < 64; ++pp) { const float vr = xsr[lstep * 65 + pp], vi = xsi[lstep * 65 + pp];
            const f32x4 c4 = *(const f32x4*)(CRs + pp * 16 + lpart * 4), d4 = *(const f32x4*)(CIs + pp * 16 + lpart * 4);
            acc += c4 * vr - d4 * vi; }
        *(f32x4*)(YS + ((size_t)b * TPB + seqpos(s0w + sub * 16 + lstep, d)) * 512 + g * 16 + lpart * 4) = acc;
    }
#undef S5_LOADU
#undef S5_STEP
}

DEV void attn_unit(const KP& p, int b, int hq, int qrow0, int nkeys) {
    const int oz = opaque0();
    const att::bf16* ZA = (const att::bf16*)(p.ws + OFF_ZA); att::bf16* O = (att::bf16*)(p.ws + OFF_O);
    const size_t base = (size_t)b * TPB; const int kvh = hq >> 2;
    __syncthreads();
    att::attn_dense_body<att::bf16>(ZA + (base + qrow0) * LD_ZA + hq * 128, ZA + base * LD_ZA + 1024 + kvh * 128, ZA + base * LD_ZA + 1280 + kvh * 128,
                                    O + (base + qrow0) * 1024 + hq * 128, nkeys, (char*)shm);
    __syncthreads();
}
DEV void phase_mix(const KP& p, int l) {
    const int oz = opaque0();
    for (int sid = obid(); sid < 256; sid += gridDim.x) s5_scan(p, l, sid);
    for (int u = obid(); u < 512; u += gridDim.x) {
        if (u < 64) rwkv_scan(p, u);
        else if (u < 128) mlstm_scan(p, l, u - 64);
        else if (u < 256 || u >= 384) { const int a = u < 256 ? u - 128 : u - 256; attn_unit(p, a >> 6, (a >> 3) & 7, 256 + (a & 7) * 256, 2304); }
        else if (u < 288) { if (l == 0) { const int a = u - 256; attn_unit(p, a >> 3, a & 7, 0, 256); } }
    }
}
DEV void phase_post(const KP& p, int l) {
    const int oz = opaque0();
    const int tid = otid(), wave = __builtin_amdgcn_readfirstlane(tid >> 6), lane = tid & 63;
    const int gw = obid() * 8 + wave, NGW = gridDim.x * 8;
    const float* SC = (const float*)(p.ws + OFF_SC); const float* ZF = (const float*)(p.ws + OFF_ZF); const float* GR = (const float*)(p.ws + OFF_RW) + 9 * SZ_RW;
    bf16_t* AB = (bf16_t*)(p.ws + OFF_AB);
    for (int tau = gw; tau < MROWS * 20; tau += NGW) {
        const int row = tau / 20, k = tau - row * 20;
        if (l == 1 && (row % TPB) < 256) continue;
        const size_t ro = (size_t)row * 512;
        if (k < 8) {
            const int j = k * 64 + lane;
            const float o = SC[0 * SZ_RW + ro + j] + SC[1 * SZ_RW + ro + j];
            const float mean = wsum(o) * (1.f / 64.f), dl = o - mean, var = wsum(dl * dl) * (1.f / 64.f);
            const float y = dl * (1.f / sqrtf(var + 64e-5f));
            AB[0 * SZ_RW + ro + j] = f2bf((y * p.in[oz + 21][l * 512 + j] + p.in[oz + 22][l * 512 + j]) * GR[ro + j]);
        } else if (k < 12) {
            const int j0 = (k - 8) * 128 + lane, j1 = j0 + 64;
            const float x0 = sigm(ZF[(size_t)row * LD_ZF + ZF_ML + 1536 + j0]) * (SC[2 * SZ_RW + ro + j0] + SC[3 * SZ_RW + ro + j0]);
            const float x1 = sigm(ZF[(size_t)row * LD_ZF + ZF_ML + 1536 + j1]) * (SC[2 * SZ_RW + ro + j1] + SC[3 * SZ_RW + ro + j1]);
            const float mean = wsum(x0 + x1) * (1.f / 128.f), d0 = x0 - mean, d1 = x1 - mean, var = wsum(d0 * d0 + d1 * d1) * (1.f / 128.f);
            const float rs = 1.f / sqrtf(var + 1e-6f);
            AB[1 * SZ_RW + ro + j0] = f2bf(d0 * rs * p.in[oz + 26][l * 512 + j0]); AB[1 * SZ_RW + ro + j1] = f2bf(d1 * rs * p.in[oz + 26][l * 512 + j1]);
        } else {
            const int j = (k - 12) * 64 + lane;
            const float y = SC[4 * SZ_RW + ro + j] + SC[5 * SZ_RW + ro + j] + ZF[(size_t)row * LD_ZF + ZF_S5 + j] * p.in[oz + 34][l * 512 + j];
            const float ge = 0.5f * y * (1.f + tanhf(0.7978845608028654f * (y + 0.044715f * y * y * y)));
            AB[2 * SZ_RW + ro + j] = f2bf(ge);
        }
    }
}

__global__ void __launch_bounds__(512, 2) hybrid_fwd(KP p) {
    cg::grid_group grid = cg::this_grid();
    otid_init();
    unsigned char* ws = p.ws;
    phase_convert(p, 0); phase_mod(p); phase_s5disc(p);
    grid.sync();
#pragma unroll 1
    for (int l = 0; l < 2; ++l) {
        const int oz = opaque0();
        const int skip = l;
        const float* MODL = (const float*)(ws + OFF_MOD) + (size_t)l * 5 * 12288;
        if (l == 1) { __syncthreads(); phase_convert(p, 1); }
        phase_norm(p, l, 0, l == 0, false);
        grid.sync();
        { EpiWin E{(bf16_t*)(ws + OFF_ZA), (float*)(ws + OFF_ZF)}; run_gemm((const bf16_t*)(ws + OFF_H), (const bf16_t*)(ws + OFF_W + W_WIN), 6144, 2048, 0, E); }
        grid.sync();
        phase_rwkvprep(p, l); phase_attnprep(p, l);
        grid.sync();
        phase_mix(p, l);
        grid.sync();
        phase_post(p, l);
        grid.sync();
        { EpiGlu2<0> E{(bf16_t*)(ws + OFF_AB) + 3 * SZ_RW, 512}; run_gemm((const bf16_t*)(ws + OFF_AB) + 2 * SZ_RW, (const bf16_t*)(ws + OFF_W + W_GL), 1024, 512, skip, E); }
        { EpiGate E{(bf16_t*)(ws + OFF_G), p.in[oz + 9] + (size_t)l * 8192}; run_gemm((const bf16_t*)(ws + OFF_H), (const bf16_t*)(ws + OFF_W + W_WG), 8192, 2048, skip, E); }
        grid.sync();
#pragma unroll 1
        for (int br = 0; br < 4; ++br) {
            EpiMerge E{(float*)(ws + OFF_YF), (bf16_t*)(ws + OFF_Y), (const bf16_t*)(ws + OFF_G), br, br == 0 ? 0 : (br == 3 ? 2 : 1)};
            const bf16_t* A = br == 0 ? (const bf16_t*)(ws + OFF_O) : (const bf16_t*)(ws + OFF_AB) + (size_t)(br == 1 ? 0 : (br == 2 ? 1 : 3)) * SZ_RW;
            const bf16_t* Bt = (const bf16_t*)(ws + OFF_W + (br == 0 ? W_BA : (br == 1 ? W_BR : (br == 2 ? W_BM : W_BS))));
            run_gemm(A, Bt, 2048, br == 0 ? 1024 : 512, skip, E);
        }
        grid.sync();
        { EpiResid E{(float*)(ws + OFF_X), MODL + 2 * 2048}; run_gemm((const bf16_t*)(ws + OFF_Y), (const bf16_t*)(ws + OFF_W + W_WO), 2048, 2048, skip, E); }
        grid.sync();
        phase_norm(p, l, 1, false, skip != 0);
        grid.sync();
        { EpiGlu2<1> E{(bf16_t*)(ws + OFF_ACT), FFN}; run_gemm((const bf16_t*)(ws + OFF_H), (const bf16_t*)(ws + OFF_W + W_FI), 11264, 2048, skip, E); }
        grid.sync();
        { EpiResid E{(float*)(ws + OFF_X), MODL + 5 * 2048}; run_gemm((const bf16_t*)(ws + OFF_ACT), (const bf16_t*)(ws + OFF_W + W_FO), 2048, FFN, skip, E); }
        grid.sync();
    }
    phase_final(p);
}

extern "C" void kernel_launch(void* const* d_in, const int* in_sizes, int n_in, void* d_out, int out_size, void* d_ws, size_t ws_size, hipStream_t stream) {
    static int grid = 0;
    if (grid == 0) {
        if (n_in != 44 || out_size != 4 * 2048 * 2048 || ws_size < WS_END) { fprintf(stderr, "kernel_launch: unexpected shapes: n_in %d out %d ws %zu (need %zu)\n", n_in, out_size, ws_size, (size_t)WS_END); grid = -1; return; }
        int dev = 0, cus = 0, per_cu = 0;
        hipGetDevice(&dev);
        hipDeviceGetAttribute(&cus, hipDeviceAttributeMultiprocessorCount, dev);
        if (hipFuncSetAttribute((const void*)hybrid_fwd, hipFuncAttributeMaxDynamicSharedMemorySize, LDS_BYTES) != hipSuccess) { fprintf(stderr, "kernel_launch: hipFuncSetAttribute failed\n"); grid = -1; return; }
        if (hipOccupancyMaxActiveBlocksPerMultiprocessor(&per_cu, (const void*)hybrid_fwd, 512, LDS_BYTES) != hipSuccess || per_cu < 1) { fprintf(stderr, "kernel_launch: occupancy query failed (%d)\n", per_cu); (void)hipGetLastError(); per_cu = 1; }
        grid = cus * per_cu;
        if (grid > 256) grid = 256;
    }
    if (grid < 0) return;
    KP p{};
    for (int i = 0; i < 44; ++i) p.in[i] = (const float*)d_in[i];
    p.out = (float*)d_out; p.ws = (unsigned char*)d_ws;
    void* args[] = {&p};
    hipError_t e = hipLaunchCooperativeKernel((const void*)hybrid_fwd, dim3(grid), dim3(512), args, LDS_BYTES, stream);
    if (e != hipSuccess) fprintf(stderr, "cooperative launch failed: %s (grid %d)\n", hipGetErrorString(e), grid);
}
```

```cpp
#include <hip/hip_runtime.h>
#include <hip/hip_cooperative_groups.h>
#include <cstdio>
#include <cstdint>
namespace cg = cooperative_groups;
extern __shared__ __attribute__((aligned(16))) unsigned char shm[];
constexpr int LDS_BYTES = 147456, WTAB_OFF = LDS_BYTES - 512, XBST_OFF = LDS_BYTES - 256;
__device__ __forceinline__ int hwslot() { return (int)(__builtin_amdgcn_s_getreg(4 | (0 << 6) | (5 << 11)) & 63u); }
__device__ __forceinline__ void otid_init() { if ((threadIdx.x & 63) == 0) ((int*)(shm + WTAB_OFF))[hwslot()] = (int)(threadIdx.x >> 6); __syncthreads(); }
__device__ __forceinline__ int otid() {
    const unsigned addr = (unsigned)(size_t)(__attribute__((address_space(3))) unsigned char*)shm + (unsigned)WTAB_OFF + 4u * (unsigned)hwslot();
    int w, lane;
    asm volatile("ds_read_b32 %0, %1\n\ts_waitcnt lgkmcnt(0)" : "=v"(w) : "v"(addr) : "memory");
    asm volatile("v_mbcnt_lo_u32_b32 %0, -1, 0\n\tv_mbcnt_hi_u32_b32 %0, -1, %0" : "=v"(lane));
    return (__builtin_amdgcn_readfirstlane(w) << 6) | lane; }
__device__ __forceinline__ int obid() { int t = (int)blockIdx.x; asm volatile("" : "+s"(t)); return t; }
namespace pg8 {
#define PG8_LAS __attribute__((address_space(3)))
typedef unsigned short bf16_t;
typedef short bf16x8 __attribute__((ext_vector_type(8)));
typedef float f32x4 __attribute__((ext_vector_type(4)));
typedef unsigned u32x4 __attribute__((ext_vector_type(4)));
constexpr int BM = 256, BK = 64, HALF = 128, HTB = HALF * BK * 2  , STAGE_BYTES = 8 * HTB, NXCD = 8, WGM = 8;

__host__ __device__ __forceinline__ int lds_byte(int r, int c) { const int st = (r >> 4) * 2 + (c >> 5), rr = r & 15, cc = c & 31, ob = rr * 64 + cc * 2; return st * 1024 + (ob ^ (((ob >> 9) & 1) << 5)); }
__host__ __device__ __forceinline__ void stage_rc(int b, int& R, int& C) { const int st = b / 1024, sb = b % 1024, swz = sb ^ (((sb >> 9) & 1) << 5); R = (st >> 1) * 16 + swz / 64; C = (st & 1) * 32 + (swz % 64) / 2; }
__host__ __device__ __forceinline__ int perm32(int rho) { const int n = rho >> 4, i = rho & 15; return 8 * (i >> 2) + 4 * n + (i & 3); }

struct Unit { int pm, pn; };
struct Gemm { const bf16_t* A; const bf16_t* Bt; int M, N, K, ld; };

struct Order {
    int nM, nN, nwg, G, c, skip;
    __device__ void init(int nM_, int N, int G_, int c_, int skip_) { nM = nM_; nN = N / BM; nwg = nM * nN; G = G_; c = c_; skip = skip_; }
    __device__ bool next(int i, Unit& u) const {
        const long L = (long)i * G + c; if (L >= nwg) return false;
        int wgid = (int)L; { const int q = nwg / NXCD, r = nwg % NXCD, xcd = wgid % NXCD, off = wgid / NXCD; wgid = (xcd < r ? xcd * (q + 1) : r * (q + 1) + (xcd - r) * q) + off; }
        const int nig = WGM * nN, gid = wgid / nig, fm = gid * WGM, gsz = (nM - fm) < WGM ? (nM - fm) : WGM;
        u.pm = fm + ((wgid % nig) % gsz); u.pn = (wgid % nig) / gsz;
        if (skip == 1) u.pm = (u.pm >> 3) * 9 + 1 + (u.pm & 7); else if (skip == 2) u.pm = u.pm * 9;
        return true;
    }
    __device__ __forceinline__ void a_ready(const Unit&) const {}
    __device__ __forceinline__ void done(const Unit&) const {}
};
__device__ __forceinline__ unsigned cvt_pk_bf16(float lo, float hi) { unsigned r; asm volatile("v_cvt_pk_bf16_f32 %0, %1, %2" : "=v"(r) : "v"(lo), "v"(hi)); return r; }
template <class Epi, class Sched, bool STAMP = false>
__device__ __forceinline__ void gemm_phase(PG8_LAS unsigned char* lds, const Gemm g, const Sched& S, const Epi& E, unsigned long long* stamps) {
    const int tid = otid(), wid = __builtin_amdgcn_readfirstlane(tid >> 6), lane = tid & 63, wr = wid >> 2, wc = wid & 3, fr = lane & 15, fq = lane >> 4;
    const int K = g.K, nt = K / BK;
    int ts_lo = 0, ts_hi = 0, nts = 0; const unsigned long long rt_entry = STAMP ? (unsigned long long)wall_clock64() : 0ull;
#define PG8_STAMP() do { if (STAMP && wid == 0 && nts < 64) { const unsigned long long _c = (unsigned long long)clock64(); \
        ts_lo = (lane == nts) ? (int)(unsigned)_c : ts_lo; ts_hi = (lane == nts) ? (int)(unsigned)(_c >> 32) : ts_hi; ++nts; } } while (0)
    PG8_STAMP();
    unsigned voffA[2], voffB[2];
#pragma unroll
    for (int i = 0; i < 2; ++i) { int R, C; stage_rc(tid * 16 + i * 8192, R, C); const int Rb = Epi::PERM ? ((R & ~31) + perm32(R & 31)) : R;
        voffA[i] = (unsigned)(R * g.ld + C) * 2u; voffB[i] = (unsigned)(Rb * g.ld + C) * 2u; }
    const size_t kstep = (size_t)(BK * 2);
    const size_t hstep = (size_t)HALF * g.ld * 2;
    const size_t tstep = 2 * hstep;
    const unsigned ldsw = (unsigned)wid * 1024u;
    const int aoff = lds_byte(wr * 64 + fr, fq * 8), boff = lds_byte(wc * 32 + fr, fq * 8);
#define PG8_SA(b, h) (((b) * 2 + (h)) * HTB)
#define PG8_SB(b, h) ((4 + (b) * 2 + (h)) * HTB)
#define PG8_STAGE(bufoff, gbase, voff) do { _Pragma("unroll") for (int _i = 0; _i < 2; ++_i) \
        __builtin_amdgcn_global_load_lds((const unsigned*)((const char*)(gbase) + (voff)[_i]), (PG8_LAS unsigned*)(lds + (bufoff) + ldsw + _i * 8192), 16, 0, 0); } while (0)
#define PG8_LDA(dst, b, h) do { _Pragma("unroll") for (int m = 0; m < 4; ++m) _Pragma("unroll") for (int k = 0; k < 2; ++k) dst[m][k] = *(const PG8_LAS bf16x8*)(lds + PG8_SA(b, h) + aoff + m * 2048 + k * 1024); } while (0)
#define PG8_LDB(dst, b, h) do { _Pragma("unroll") for (int n = 0; n < 2; ++n) _Pragma("unroll") for (int k = 0; k < 2; ++k) dst[n][k] = *(const PG8_LAS bf16x8*)(lds + PG8_SB(b, h) + boff + n * 2048 + k * 1024); } while (0)
#define PG8_MMA(ai, bj, At, Bt) do { __builtin_amdgcn_s_setprio(1); _Pragma("unroll") for (int m = 0; m < 4; ++m) _Pragma("unroll") for (int n = 0; n < 2; ++n) _Pragma("unroll") for (int k = 0; k < 2; ++k) \
        acc[ai][bj][m][n] = __builtin_amdgcn_mfma_f32_16x16x32_bf16(Bt[n][k], At[m][k], acc[ai][bj][m][n], 0, 0, 0); __builtin_amdgcn_s_setprio(0); } while (0)
#define PG8_WAIT_V(n) asm volatile("s_waitcnt vmcnt(" #n ")" ::: "memory")
#define PG8_WAIT_L(n) asm volatile("s_waitcnt lgkmcnt(" #n ")" ::: "memory")
#define PG8_BAR __builtin_amdgcn_s_barrier()
#define PG8_SCHED __builtin_amdgcn_sched_barrier(0)
    Unit cur, nxt; int ui = 0;
    if (!S.next(0, cur)) return;
    f32x4 acc[2][2][4][2];
#pragma unroll
    for (int a = 0; a < 2; ++a)
#pragma unroll
        for (int b = 0; b < 2; ++b)
#pragma unroll
            for (int m = 0; m < 4; ++m)
#pragma unroll
                for (int n = 0; n < 2; ++n) acc[a][b][m][n] = (f32x4){0.f, 0.f, 0.f, 0.f};
    bf16x8 At[4][2], B0[2][2], B1[2][2];
    const char* cA = (const char*)g.A + (size_t)cur.pm * tstep; const char* cB = (const char*)g.Bt + (size_t)cur.pn * tstep;
    S.a_ready(cur);
    PG8_STAGE(PG8_SB(0, 0), cB, voffB); PG8_STAGE(PG8_SA(0, 0), cA, voffA); PG8_STAGE(PG8_SB(0, 1), cB + hstep, voffB); PG8_STAGE(PG8_SA(0, 1), cA + hstep, voffA);
    if (wr == 1) PG8_BAR;
    PG8_WAIT_V(4); PG8_BAR;
    PG8_STAGE(PG8_SB(1, 0), cB + kstep, voffB); PG8_STAGE(PG8_SA(1, 0), cA + kstep, voffA); PG8_STAGE(PG8_SB(1, 1), cB + hstep + kstep, voffB);
    PG8_WAIT_V(6); PG8_BAR;
    PG8_STAMP();
    for (;;) {
        const bool has_next = S.next(ui + 1, nxt);
        const char* nA = has_next ? (const char*)g.A + (size_t)nxt.pm * tstep : cA; const char* nB = has_next ? (const char*)g.Bt + (size_t)nxt.pn * tstep : cB;
        for (int t = 0; t < nt; t += 2) {
            const bool last = (t == nt - 2);
            const char* a1 = cA + (size_t)(t + 1) * kstep;
            const char* a2 = last ? nA : cA + (size_t)(t + 2) * kstep; const char* b2 = last ? nB : cB + (size_t)(t + 2) * kstep;
            const char* a3 = a2 + kstep; const char* b3 = b2 + kstep;
            if (last && has_next) S.a_ready(nxt);
            PG8_LDB(B0, 0, 0); PG8_SCHED; PG8_LDA(At, 0, 0); PG8_STAGE(PG8_SA(1, 1), a1 + hstep, voffA);
            PG8_WAIT_L(8); PG8_BAR; PG8_WAIT_L(0); PG8_MMA(0, 0, At, B0); PG8_BAR; PG8_SCHED;
            PG8_LDB(B1, 0, 1); PG8_STAGE(PG8_SB(0, 0), b2, voffB);
            PG8_BAR; PG8_WAIT_L(0); PG8_MMA(0, 1, At, B1); PG8_BAR;
            PG8_LDA(At, 0, 1); PG8_STAGE(PG8_SA(0, 0), a2, voffA);
            PG8_BAR; PG8_WAIT_L(0); PG8_MMA(1, 0, At, B0); PG8_BAR; PG8_SCHED;
            PG8_STAGE(PG8_SB(0, 1), b2 + hstep, voffB);
            PG8_WAIT_V(6); PG8_BAR; PG8_MMA(1, 1, At, B1); PG8_BAR;
            PG8_LDB(B0, 1, 0); PG8_SCHED; PG8_LDA(At, 1, 0); PG8_STAGE(PG8_SA(0, 1), a2 + hstep, voffA);
            PG8_WAIT_L(8); PG8_BAR; PG8_WAIT_L(0); PG8_MMA(0, 0, At, B0); PG8_BAR; PG8_SCHED;
            PG8_LDB(B1, 1, 1); PG8_STAGE(PG8_SB(1, 0), b3, voffB);
            PG8_BAR; PG8_WAIT_L(0); PG8_MMA(0, 1, At, B1); PG8_BAR;
            PG8_LDA(At, 1, 1); PG8_STAGE(PG8_SA(1, 0), a3, voffA);
            PG8_BAR; PG8_WAIT_L(0); PG8_MMA(1, 0, At, B0); PG8_BAR; PG8_SCHED;
            PG8_STAGE(PG8_SB(1, 1), b3 + hstep, voffB);
            PG8_WAIT_V(6); PG8_BAR; PG8_MMA(1, 1, At, B1); PG8_BAR;
        }
        PG8_STAMP();
        if constexpr (!Epi::AFTER_DRAIN) { E(acc, cur, wr, wc, fr, fq); S.done(cur); }
        PG8_STAMP();
        if (!has_next) break;
#pragma unroll
        for (int a = 0; a < 2; ++a)
#pragma unroll
            for (int b = 0; b < 2; ++b)
#pragma unroll
                for (int m = 0; m < 4; ++m)
#pragma unroll
                    for (int n = 0; n < 2; ++n) acc[a][b][m][n] = (f32x4){0.f, 0.f, 0.f, 0.f};
        cur = nxt; cA = nA; cB = nB; ++ui;
    }
    PG8_WAIT_V(0);
    if (wr == 0) PG8_BAR;
    PG8_BAR;
    if constexpr (Epi::AFTER_DRAIN) { E.fused(acc, cur, wr, wc, fr, fq, lds, wid, lane); S.done(cur); }
    PG8_STAMP();
    if (STAMP && wid == 0) { stamps[lane] = lane < nts ? (((unsigned long long)(unsigned)ts_hi << 32) | (unsigned)ts_lo) : 0ull;
        if (lane == 62) stamps[62] = rt_entry; if (lane == 63) stamps[63] = (unsigned long long)wall_clock64(); }
#undef PG8_STAMP
#undef PG8_SA
#undef PG8_SB
#undef PG8_STAGE
#undef PG8_LDA
#undef PG8_LDB
#undef PG8_MMA
#undef PG8_WAIT_V
#undef PG8_WAIT_L
#undef PG8_BAR
#undef PG8_SCHED
}
}

namespace att {
using bf16 = unsigned short;
constexpr int   D = 128, NW = 8, QBLK = 32, KVBLK = 64;
constexpr float SCALE = 0.088388347648318440f;
constexpr float THR = 8.f;
constexpr int SDEPTH = 2;
constexpr int LDQ = 1536, LDK = 1536, LDO = 1024;
constexpr size_t SHM_V = KVBLK * D * 2, SHM_K = KVBLK * D * 2, SHM_ATTN = 2 * SHM_V + 2 * SHM_K + NW * 64 * 4;
__device__ __forceinline__ unsigned short f2bf_att(float f) { unsigned u = __float_as_uint(f); u += 0x7FFFu + ((u >> 16) & 1u); return (unsigned short)(u >> 16); }
using bf16x8 = __attribute__((ext_vector_type(8))) short;
using s16x4  = __attribute__((ext_vector_type(4))) short;
using f32x16 = __attribute__((ext_vector_type(16))) float;
using f32x8  = __attribute__((ext_vector_type(8))) float;
using u32x4  = __attribute__((ext_vector_type(4))) unsigned;
#define KSWZ(row, colB) ((row) * 256 + ((colB) ^ (((row) & 7) << 4)))
#define SBAR() __builtin_amdgcn_sched_barrier(0)
__device__ __forceinline__ int crow(int r, int hi) { return (r & 3) + 8 * (r >> 2) + 4 * hi; }
__device__ __forceinline__ unsigned cvtpk(float lo, float hi) {
  unsigned r; asm volatile("v_cvt_pk_bf16_f32 %0, %1, %2" : "=v"(r) : "v"(lo), "v"(hi)); return r;
}
template <typename TIn> struct Stage;
template <> struct Stage<bf16>  { using T = bf16x8;
  __device__ static __forceinline__ T ld8(const bf16* p) { return *reinterpret_cast<const bf16x8*>(p); }
  __device__ static __forceinline__ bf16x8 tobf(T x) { return x; } };
template <> struct Stage<float> { using T = f32x8;
  __device__ static __forceinline__ T ld8(const float* p) { return *reinterpret_cast<const f32x8*>(p); }
  __device__ static __forceinline__ bf16x8 tobf(T x) {
    u32x4 w = {cvtpk(x[0], x[1]), cvtpk(x[2], x[3]), cvtpk(x[4], x[5]), cvtpk(x[6], x[7])}; return *reinterpret_cast<bf16x8*>(&w); } };

__device__ __forceinline__ void partialSM(f32x16& p0, f32x16& p1, float& m_reg, float& mn, float& alpha) {
  constexpr float C = SCALE * 1.4426950408889634f;
  float pmax = p0[0]; for (int r = 1; r < 16; ++r) pmax = fmaxf(pmax, p0[r]); for (int r = 0; r < 16; ++r) pmax = fmaxf(pmax, p1[r]);
  { auto rr = __builtin_amdgcn_permlane32_swap(__float_as_uint(pmax), __float_as_uint(pmax), false, false);
    pmax = fmaxf(__uint_as_float(rr[0]), __uint_as_float(rr[1])); }
  if (__builtin_expect(__all(pmax - m_reg <= THR / SCALE), 1)) { mn = m_reg; alpha = 1.f; }
  else { mn = fmaxf(m_reg, pmax); alpha = __builtin_amdgcn_exp2f((m_reg - mn) * C); m_reg = mn; }
  float mnC = -mn * C;
  for (int r = 0; r < 16; ++r) p0[r] = fmaf(p0[r], C, mnC); for (int r = 0; r < 16; ++r) p1[r] = fmaf(p1[r], C, mnC);
  for (int r = 0; r < 16; ++r) p0[r] = __builtin_amdgcn_exp2f(p0[r]);
}
__device__ __forceinline__ void finishSM(f32x16& p0, f32x16& p1, float alpha, float& l_reg, bf16x8& pa0, bf16x8& pa1, bf16x8& pa2, bf16x8& pa3) {
  for (int r = 0; r < 16; ++r) p1[r] = __builtin_amdgcn_exp2f(p1[r]);
  float ps = 0; for (int r = 0; r < 16; ++r) ps += p0[r]; for (int r = 0; r < 16; ++r) ps += p1[r];
  { auto rr = __builtin_amdgcn_permlane32_swap(__float_as_uint(ps), __float_as_uint(ps), false, false);
    ps = __uint_as_float(rr[0]) + __uint_as_float(rr[1]); }
  l_reg = l_reg * alpha + ps;
#define PK4(P, BASE, OUT) do { unsigned a0 = cvtpk(P[BASE + 0], P[BASE + 1]), a1 = cvtpk(P[BASE + 2], P[BASE + 3]);   \
    unsigned b0 = cvtpk(P[BASE + 4], P[BASE + 5]), b1 = cvtpk(P[BASE + 6], P[BASE + 7]);                              \
    auto r0 = __builtin_amdgcn_permlane32_swap(a0, b0, false, false); auto r1 = __builtin_amdgcn_permlane32_swap(a1, b1, false, false); \
    u32x4 w = {r0[0], r1[0], r0[1], r1[1]}; OUT = *reinterpret_cast<bf16x8*>(&w); } while (0)
  PK4(p0, 0, pa0); PK4(p0, 8, pa1); PK4(p1, 0, pa2); PK4(p1, 8, pa3);
#undef PK4
}
__device__ __forceinline__ void qkt(f32x16& p0, f32x16& p1, const bf16* Ks, const bf16x8* qr, int r32, int hi) {
  p0 = f32x16{}; p1 = f32x16{};
  for (int d0 = 0; d0 < 8; ++d0) { int cb = (d0 * 16 + hi * 8) * 2;
    bf16x8 b0 = *reinterpret_cast<const bf16x8*>((const char*)Ks + KSWZ(r32, cb));
    bf16x8 b1 = *reinterpret_cast<const bf16x8*>((const char*)Ks + KSWZ(32 + r32, cb));
    p0 = __builtin_amdgcn_mfma_f32_32x32x16_bf16(b0, qr[d0], p0, 0, 0, 0);
    p1 = __builtin_amdgcn_mfma_f32_32x32x16_bf16(b1, qr[d0], p1, 0, 0, 0); }
}
__device__ __forceinline__ int v_st(int k, int c) { const int kk = (k & ~0xC) | ((k & 4) << 1) | ((k & 8) >> 1); return ((kk >> 3) * 4 + (c >> 5)) * 512 + ((kk & 7) * 32 + (c & 31)) * 2; }
__device__ __forceinline__ int v_rd_base(int lane) { return ((lane & 3) << 3) | (((lane >> 2) & 3) << 6) | (((lane >> 4) & 1) << 5) | (((lane >> 5) & 1) << 8); }
constexpr int v_rd_off(int d0, int ks, int half) { return d0 * 512 + ks * 4096 + half * 2048; }
template <int OFF> __device__ __forceinline__ s16x4 tr_read(int vb) {
  s16x4 r; asm volatile("ds_read_b64_tr_b16 %0, %1 offset:%2" : "=&v"(r) : "v"(vb), "i"(OFF) : "memory"); return r;
}
template <int D0> __device__ __forceinline__ void pv_one(f32x16& od, int vb, bf16x8 pa0, bf16x8 pa1, bf16x8 pa2, bf16x8 pa3) {
  const s16x4 l0 = tr_read<v_rd_off(D0, 0, 0)>(vb), h0 = tr_read<v_rd_off(D0, 0, 1)>(vb), l1 = tr_read<v_rd_off(D0, 1, 0)>(vb), h1 = tr_read<v_rd_off(D0, 1, 1)>(vb);
  const s16x4 l2 = tr_read<v_rd_off(D0, 2, 0)>(vb), h2 = tr_read<v_rd_off(D0, 2, 1)>(vb), l3 = tr_read<v_rd_off(D0, 3, 0)>(vb), h3 = tr_read<v_rd_off(D0, 3, 1)>(vb);
  asm volatile("s_waitcnt lgkmcnt(0)" ::: "memory"); SBAR();
#define PK(L, H) (bf16x8){L[0], L[1], L[2], L[3], H[0], H[1], H[2], H[3]}
  od = __builtin_amdgcn_mfma_f32_32x32x16_bf16(pa0, PK(l0, h0), od, 0, 0, 0);
  od = __builtin_amdgcn_mfma_f32_32x32x16_bf16(pa1, PK(l1, h1), od, 0, 0, 0);
  od = __builtin_amdgcn_mfma_f32_32x32x16_bf16(pa2, PK(l2, h2), od, 0, 0, 0);
  od = __builtin_amdgcn_mfma_f32_32x32x16_bf16(pa3, PK(l3, h3), od, 0, 0, 0);
#undef PK
}
__device__ __forceinline__ void pv_d0(f32x16* o, int vb, bf16x8 pa0, bf16x8 pa1, bf16x8 pa2, bf16x8 pa3) {
  pv_one<0>(o[0], vb, pa0, pa1, pa2, pa3); pv_one<1>(o[1], vb, pa0, pa1, pa2, pa3); pv_one<2>(o[2], vb, pa0, pa1, pa2, pa3); pv_one<3>(o[3], vb, pa0, pa1, pa2, pa3);
}

template <typename TQ>
__device__ __forceinline__ void attn_dense_body(const TQ* __restrict__ Qb, const bf16* __restrict__ Kh, const bf16* __restrict__ Vh,
                                                bf16* __restrict__ Ob, int seq, char* lds) {
  using St = Stage<bf16>; using SQ = Stage<TQ>;
  const int tid = otid(), wid = tid >> 6, lane = tid & 63, r32 = lane & 31, hi = lane >> 5;
  bf16* V_lds = (bf16*)lds; bf16* K_lds = (bf16*)(lds + 2 * SHM_V);
  float* ws = (float*)(lds + 2 * SHM_V + 2 * SHM_K) + wid * 64; float* li_l = ws; float* al_l = ws + 32;
  float m_reg = -1e30f, l_reg = 0; f32x16 o[4] = {}; bf16x8 qr[8];
  const TQ* Qw = Qb + (int)(wid * QBLK + r32) * LDQ + hi * 8;
#pragma unroll
  for (int d0 = 0; d0 < 8; ++d0) qr[d0] = SQ::tobf(SQ::ld8(Qw + d0 * 16));
  const int sr = tid >> 4, sc = (tid & 15) * 8, vst0 = v_st(sr, sc), vst1 = v_st(32 + sr, sc);
  const int vb0 = (int)(uintptr_t)V_lds + v_rd_base(lane);
  struct { typename St::T vs0, vs1, ks0, ks1; } sr_[SDEPTH];
#define SLOAD(i, k0) do { sr_[i].vs0 = St::ld8(&Vh[(int)((k0) + sr) * LDK + sc]); sr_[i].vs1 = St::ld8(&Vh[(int)((k0) + 32 + sr) * LDK + sc]); \
    sr_[i].ks0 = St::ld8(&Kh[(int)((k0) + sr) * LDK + sc]); sr_[i].ks1 = St::ld8(&Kh[(int)((k0) + 32 + sr) * LDK + sc]); } while (0)
#define SWRITE(b, i) do { *(bf16x8*)((char*)V_lds + (b) * SHM_V + vst0) = St::tobf(sr_[i].vs0);          \
    *(bf16x8*)((char*)V_lds + (b) * SHM_V + vst1) = St::tobf(sr_[i].vs1); int kc = sc * 2;               \
    *(bf16x8*)((char*)K_lds + (b) * SHM_K + KSWZ(sr, kc)) = St::tobf(sr_[i].ks0);                       \
    *(bf16x8*)((char*)K_lds + (b) * SHM_K + KSWZ(32 + sr, kc)) = St::tobf(sr_[i].ks1); } while (0)
#define SWAIT() do { if constexpr (SDEPTH == 2) asm volatile("s_waitcnt vmcnt(4)" ::: "memory"); else asm volatile("s_waitcnt vmcnt(0)" ::: "memory"); } while (0)
#define RESC(a) do { if (__any((a) < 1.f)) { if (hi == 0) al_l[r32] = (a); asm volatile("s_waitcnt lgkmcnt(0)" ::: "memory"); \
    for (int d = 0; d < 4; ++d) for (int r = 0; r < 16; ++r) o[d][r] *= al_l[crow(r, hi)]; } } while (0)
  f32x16 pA0, pA1, pB0, pB1; float mnA, mnB, alA, alB; bf16x8 pa0, pa1, pa2, pa3; const int NT = seq / KVBLK;
  constexpr int SE = 0, SO = SDEPTH - 1;
  SLOAD(SE, 0); asm volatile("s_waitcnt vmcnt(0)" ::: "memory"); SWRITE(0, SE); __syncthreads();
  qkt(pA0, pA1, K_lds, qr, r32, hi); partialSM(pA0, pA1, m_reg, mnA, alA);
  SLOAD(SO, KVBLK); if constexpr (SDEPTH == 2) { if (2 < NT) SLOAD(SE, 2 * KVBLK); }
  SWAIT(); SWRITE(1, SO); __syncthreads();
  for (int j = 1; j + 1 < NT; j += 2) {
    SBAR(); qkt(pB0, pB1, (bf16*)((char*)K_lds + SHM_K), qr, r32, hi);
    finishSM(pA0, pA1, alA, l_reg, pa0, pa1, pa2, pa3); SBAR();
    SLOAD(SO, (j + SDEPTH) * KVBLK); SBAR();
    pv_d0(o, vb0, pa0, pa1, pa2, pa3); partialSM(pB0, pB1, m_reg, mnB, alB);
    __syncthreads(); SWAIT(); SWRITE(0, SE);
    RESC(alB); __syncthreads();
    SBAR(); qkt(pA0, pA1, K_lds, qr, r32, hi);
    finishSM(pB0, pB1, alB, l_reg, pa0, pa1, pa2, pa3); SBAR();
    if (SDEPTH == 1 || j + 3 < NT) SLOAD(SE, (j + 1 + SDEPTH) * KVBLK); SBAR();
    pv_d0(o, vb0 + (int)SHM_V, pa0, pa1, pa2, pa3); partialSM(pA0, pA1, m_reg, mnA, alA);
    __syncthreads(); SWAIT(); SWRITE(1, SO);
    RESC(alA); __syncthreads();
  }
  SBAR(); qkt(pB0, pB1, (bf16*)((char*)K_lds + SHM_K), qr, r32, hi);
  finishSM(pA0, pA1, alA, l_reg, pa0, pa1, pa2, pa3); SBAR();
  pv_d0(o, vb0, pa0, pa1, pa2, pa3); partialSM(pB0, pB1, m_reg, mnB, alB);
  __syncthreads(); RESC(alB);
  finishSM(pB0, pB1, alB, l_reg, pa0, pa1, pa2, pa3); SBAR();
  pv_d0(o, vb0 + (int)SHM_V, pa0, pa1, pa2, pa3);
  if (hi == 0) li_l[r32] = l_reg; asm volatile("s_waitcnt lgkmcnt(0)" ::: "memory");
  float rli[16];
#pragma unroll
  for (int r = 0; r < 16; ++r) rli[r] = __builtin_amdgcn_rcpf(li_l[crow(r, hi)]);
  bf16* Ow = Ob + (int)(wid * QBLK) * LDO;
#pragma unroll
  for (int r = 0; r < 16; ++r) { int orow = crow(r, hi);
    for (int d0 = 0; d0 < 4; ++d0) Ow[(int)orow * LDO + d0 * 32 + r32] = f2bf_att(o[d0][r] * rli[r]); }
#undef SLOAD
#undef SWRITE
#undef SWAIT
#undef RESC
}

}

#define XB_TMO      128
#define XB_XCNT(j)  (256  + 64 * (j))
#define XB_XSUB(j)  (1280 + 64 * (j))
#define XB_XGEN(j)  (2304 + 64 * (j))
#define XB_TOP      3328
#define XB_TOPGEN   3392
#define XCD_BAR_WORDS 3456
#define XB_SPIN_CAP (1u << 20)
#define XB_LAS __attribute__((address_space(3)))

__device__ __forceinline__ unsigned xb_ld(unsigned* p)              { return __hip_atomic_load(p, __ATOMIC_RELAXED, __HIP_MEMORY_SCOPE_AGENT); }
__device__ __forceinline__ unsigned xb_add(unsigned* p, unsigned v) { return __hip_atomic_fetch_add(p, v, __ATOMIC_RELAXED, __HIP_MEMORY_SCOPE_AGENT); }
__device__ __forceinline__ unsigned xb_xcc_id() { return (unsigned)__builtin_amdgcn_s_getreg((3 << 11) | 20) & 0xFu; }
#define XB_SPIN(cond, bar) do { unsigned _sp = 0; while (cond) { __builtin_amdgcn_s_sleep(1); \
    if ((++_sp & 255u) == 0u) { if (xb_ld(&(bar)[XB_TMO])) break; if (_sp > XB_SPIN_CAP) { atomicAdd(&(bar)[XB_TMO], 1u); break; } } } } while (0)

struct XcdBarrier {
    unsigned* bar; unsigned x;
    volatile XB_LAS unsigned* st;
};

__device__ __forceinline__ XcdBarrier xcd_barrier_post(unsigned* bar, volatile XB_LAS unsigned* st) {
    XcdBarrier b; b.bar = bar; b.x = xb_xcc_id(); b.st = st;
    if (otid() == 0) (void)xb_add(&bar[XB_XCNT(b.x)], 1u);
    return b;
}
__device__ __forceinline__ void xcd_barrier_complete(unsigned* bar, unsigned x, unsigned& nloc, unsigned& nx) {
    const unsigned G = gridDim.x * gridDim.y * gridDim.z;
    unsigned sum, cnt, mine, sp = 0u;
    for (;;) {
        sum = 0u; cnt = 0u; mine = 0u;
#pragma unroll
        for (unsigned j = 0; j < 16; ++j) { const unsigned c = xb_ld(&bar[XB_XCNT(j)]); sum += c; cnt += (c > 0u) ? 1u : 0u; mine = (j == x) ? c : mine; }
        if (sum == G) break;
        __builtin_amdgcn_s_sleep(1);
        if ((++sp & 255u) == 0u) { if (xb_ld(&bar[XB_TMO])) break; if (sp > XB_SPIN_CAP) { atomicAdd(&bar[XB_TMO], 1u); break; } }
    }
    nloc = mine > 0u ? mine : 1u; nx = cnt > 0u ? cnt : 1u;
}

__device__ __forceinline__ void xcd_barrier(const XcdBarrier& b) {
    asm volatile("s_waitcnt vmcnt(0)" ::: "memory");
    __syncthreads();
    if (otid() == 0) {
        unsigned* bar = b.bar;
        __builtin_amdgcn_s_waitcnt(0);
        unsigned nloc = b.st[0], nx = b.st[1];
        if (nloc == 0u) { xcd_barrier_complete(bar, b.x, nloc, nx); b.st[0] = nloc; b.st[1] = nx; }
        const unsigned old = xb_add(&bar[XB_XSUB(b.x)], 1u);
        const unsigned gen = old / nloc;
        if (old + 1u == (gen + 1u) * nloc) {
            __builtin_amdgcn_fence(__ATOMIC_RELEASE, "agent");
            asm volatile("s_waitcnt vmcnt(0)" ::: "memory");
            const unsigned og = xb_add(&bar[XB_TOP], 1u);
            const unsigned tg = og / nx;
            if (og + 1u == (tg + 1u) * nx) xb_add(&bar[XB_TOPGEN], 1u);
            else XB_SPIN(xb_ld(&bar[XB_TOPGEN]) == tg, bar);
            __builtin_amdgcn_fence(__ATOMIC_ACQUIRE, "agent");
            xb_add(&bar[XB_XGEN(b.x)], 1u);
            asm volatile("s_waitcnt vmcnt(0)" ::: "memory");
        } else {
            XB_SPIN(xb_ld(&bar[XB_XGEN(b.x)]) == gen, bar);
            __builtin_amdgcn_fence(__ATOMIC_ACQUIRE, "agent");
            asm volatile("s_waitcnt vmcnt(0)" ::: "memory");
        }
    }
    __syncthreads();
}


#define DEV __device__ __forceinline__
typedef unsigned short bf16_t;
typedef float f32x4 __attribute__((ext_vector_type(4)));
typedef float f32x2 __attribute__((ext_vector_type(2)));
typedef float f32x16 __attribute__((ext_vector_type(16)));
typedef short bf16x8 __attribute__((ext_vector_type(8)));
typedef unsigned u32x2 __attribute__((ext_vector_type(2)));
typedef unsigned u32x4 __attribute__((ext_vector_type(4)));

constexpr int MROWS = 9216, TPB = 2304;
constexpr int LD_ZA = 1536, LD_ZF = 4608;
constexpr int ZF_ML = 1792, ZF_MLG = 3840, ZF_S5 = 4096;
constexpr int FFN = 5632;
constexpr size_t SZ_RW = (size_t)MROWS * 512;
constexpr size_t W_WIN = 0, W_WG = W_WIN + 6144ull * 2048 * 2, W_BA = W_WG + 8192ull * 2048 * 2, W_BR = W_BA + 2048ull * 1024 * 2, W_BM = W_BR + 2048ull * 512 * 2,
                 W_BS = W_BM + 2048ull * 512 * 2, W_WO = W_BS + 2048ull * 512 * 2, W_FI = W_WO + 2048ull * 2048 * 2, W_FO = W_FI + 11264ull * 2048 * 2,
                 W_GL = W_FO + 2048ull * 5632 * 2, W_LW = W_GL + 1024ull * 512 * 2  ,
                 W_END = W_LW + 4 * 512ull * 64 * 2 + 512ull * 128 * 2;
constexpr size_t OFF_W = 0;
constexpr size_t OFF_X = OFF_W + W_END;
constexpr size_t OFF_H = OFF_X + (size_t)MROWS * 2048 * 4;
constexpr size_t OFF_ZA = OFF_H + (size_t)MROWS * 2048 * 2;
constexpr size_t OFF_ZF = OFF_ZA + (size_t)MROWS * 1536 * 2;
constexpr size_t OFF_O = OFF_ZF + (size_t)MROWS * 4608 * 4;
constexpr size_t OFF_RW = OFF_O + (size_t)MROWS * 1024 * 2;
constexpr size_t OFF_C12 = OFF_RW + 10 * SZ_RW * 4;
constexpr size_t OFF_SC = OFF_C12 + 2ull * MROWS * 16 * 4;
constexpr size_t OFF_AB = OFF_SC + 6 * SZ_RW * 4;
constexpr size_t OFF_MOD = OFF_AB + 4 * SZ_RW * 2;
constexpr size_t OFF_ABAR = OFF_MOD + 2ull * 5 * 12288 * 4;
constexpr size_t OFF_BBAR = OFF_ABAR + 8192ull * 2 * 4;
constexpr size_t OFF_BAR = OFF_BBAR + 8192ull * 32 * 4;
constexpr size_t WS_END = OFF_BAR + 16384;
constexpr size_t OFF_G = OFF_RW;
constexpr size_t OFF_P = OFF_ZF;
constexpr size_t OFF_Y = OFF_H;
constexpr size_t OFF_ACT = OFF_ZF;
constexpr size_t OFF_PART = OFF_ZF + 112ull * 1048576;
static_assert((size_t)MROWS * 8192 * 2 <= 10 * SZ_RW * 4, "G overlay");
static_assert((size_t)MROWS * 2048 * 8 <= (size_t)MROWS * 4608 * 4 && (size_t)MROWS * 5632 * 2 <= (size_t)MROWS * 4608 * 4, "ZF overlays");
static_assert(OFF_ACT + (size_t)MROWS * 5632 * 2 <= OFF_PART && OFF_PART + 4ull * 1024 * 2048 * 2 <= OFF_ZF + (size_t)MROWS * 4608 * 4, "partials overlay");

struct KP { const float* in[44]; float* out; unsigned char* ws; };


DEV int opaque0() { int z; asm volatile("s_mov_b32 %0, 0" : "=s"(z)); return z; }
DEV unsigned char* wsp(const KP& p) { return p.ws + (size_t)(unsigned)opaque0(); }
template <int CTRL> DEV float dppf(float v) { return __builtin_bit_cast(float, __builtin_amdgcn_update_dpp(0, __builtin_bit_cast(int, v), CTRL, 0xF, 0xF, true)); }
DEV float wsum(float v) {
    v += dppf<0xB1>(v); v += dppf<0x4E>(v); v += dppf<0x141>(v); v += dppf<0x140>(v);
    const float a = __builtin_bit_cast(float, __builtin_amdgcn_readlane(__builtin_bit_cast(int, v), 0)), b = __builtin_bit_cast(float, __builtin_amdgcn_readlane(__builtin_bit_cast(int, v), 16));
    const float c = __builtin_bit_cast(float, __builtin_amdgcn_readlane(__builtin_bit_cast(int, v), 32)), d = __builtin_bit_cast(float, __builtin_amdgcn_readlane(__builtin_bit_cast(int, v), 48));
    return (a + b) + (c + d);
}
DEV float sigm(float x) { return 1.f / (1.f + __expf(-x)); }
DEV float siluf(float x) { return x / (1.f + __expf(-x)); }
typedef __bf16 bf16x2_t __attribute__((ext_vector_type(2)));
DEV unsigned pk2(float lo, float hi) { f32x2 f = {lo, hi}; bf16x2_t r = __builtin_convertvector(f, bf16x2_t); return __builtin_bit_cast(unsigned, r); }
DEV bf16_t f2bf(float f) { unsigned u = __float_as_uint(f); u += 0x7FFFu + ((u >> 16) & 1u); return (bf16_t)(u >> 16); }
DEV float bf2f(bf16_t b) { return __uint_as_float(((unsigned)b) << 16); }
DEV void lds_wait() { asm volatile("s_waitcnt lgkmcnt(0)" ::: "memory"); }
DEV int seqpos(int s, int d) { return d == 0 ? s : (s < 256 ? 255 - s : 2559 - s); }
DEV int crow16(int r, int hi) { return (r & 3) + 8 * (r >> 2) + 4 * hi; }

DEV void st16(void* ptr, u32x4 v) { *(u32x4*)ptr = v; }
DEV void st16f(void* ptr, f32x4 v) { *(f32x4*)ptr = v; }
DEV u32x4 pack8(const f32x4 a, const f32x4 b) { u32x4 o; o.x = pk2(a[0], a[1]); o.y = pk2(a[2], a[3]); o.z = pk2(b[0], b[1]); o.w = pk2(b[2], b[3]); return o; }
struct EpiWin {
    static constexpr bool PERM = true, AFTER_DRAIN = false;
    bf16_t* ZA; float* ZF;
    DEV void operator()(const pg8::f32x4 (&acc)[2][2][4][2], const pg8::Unit& u, int wr, int wc, int fr, int fq) const {
        const int row0 = u.pm * 256 + wr * 64 + fr, cb0 = u.pn * 256 + wc * 32 + 8 * fq;
#pragma unroll
        for (int ai = 0; ai < 2; ++ai)
#pragma unroll
            for (int m = 0; m < 4; ++m) { const size_t row = row0 + ai * 128 + m * 16;
#pragma unroll
                for (int bj = 0; bj < 2; ++bj) { const int cb = cb0 + bj * 128; const f32x4 v0 = acc[ai][bj][m][0], v1 = acc[ai][bj][m][1];
                    if (u.pn < 6) st16(ZA + row * LD_ZA + cb, pack8(v0, v1));
                    else { float* zp = ZF + row * LD_ZF + (cb - 1536); st16f(zp, v0); st16f(zp + 4, v1); } } }
    }
};
struct EpiGate {
    static constexpr bool PERM = true, AFTER_DRAIN = false;
    bf16_t* G; const float* bg;
    DEV void operator()(const pg8::f32x4 (&acc)[2][2][4][2], const pg8::Unit& u, int wr, int wc, int fr, int fq) const {
        const int row0 = u.pm * 256 + wr * 64 + fr, cb0 = u.pn * 256 + wc * 32 + 8 * fq;
        f32x4 bv[2][2];
#pragma unroll
        for (int bj = 0; bj < 2; ++bj)
#pragma unroll
            for (int n = 0; n < 2; ++n) bv[bj][n] = *(const f32x4*)(bg + cb0 + bj * 128 + 4 * n);
#pragma unroll
        for (int ai = 0; ai < 2; ++ai)
#pragma unroll
            for (int m = 0; m < 4; ++m) { const size_t row = row0 + ai * 128 + m * 16;
#pragma unroll
                for (int bj = 0; bj < 2; ++bj) { f32x4 s0, s1;
#pragma unroll
                    for (int i = 0; i < 4; ++i) { s0[i] = sigm(acc[ai][bj][m][0][i] + bv[bj][0][i]); s1[i] = sigm(acc[ai][bj][m][1][i] + bv[bj][1][i]); }
                    st16(G + row * 8192 + cb0 + bj * 128, pack8(s0, s1)); } }
    }
};
template <int ACT> struct EpiGlu2 {
    static constexpr bool PERM = true, AFTER_DRAIN = false;
    bf16_t* O; int ldo;
    DEV void operator()(const pg8::f32x4 (&acc)[2][2][4][2], const pg8::Unit& u, int wr, int wc, int fr, int fq) const {
        const int row0 = u.pm * 256 + wr * 64 + fr, col0 = u.pn * 128 + wc * 32 + 8 * fq;
#pragma unroll
        for (int ai = 0; ai < 2; ++ai)
#pragma unroll
            for (int m = 0; m < 4; ++m) { const size_t row = row0 + ai * 128 + m * 16; f32x4 r[2];
#pragma unroll
                for (int n = 0; n < 2; ++n) { const pg8::f32x4 a = acc[ai][0][m][n], b = acc[ai][1][m][n];
#pragma unroll
                    for (int i = 0; i < 4; ++i) r[n][i] = ACT == 0 ? a[i] * sigm(b[i]) : siluf(a[i]) * b[i]; }
                st16(O + row * ldo + col0, pack8(r[0], r[1])); }
    }
};
struct EpiPlain {
    static constexpr bool PERM = true, AFTER_DRAIN = false;
    bf16_t* P;
    DEV void operator()(const pg8::f32x4 (&acc)[2][2][4][2], const pg8::Unit& u, int wr, int wc, int fr, int fq) const {
        const int row0 = u.pm * 256 + wr * 64 + fr, cb0 = u.pn * 256 + wc * 32 + 8 * fq;
#pragma unroll
        for (int ai = 0; ai < 2; ++ai)
#pragma unroll
            for (int m = 0; m < 4; ++m) { const size_t row = row0 + ai * 128 + m * 16;
#pragma unroll
                for (int bj = 0; bj < 2; ++bj) st16(P + row * 2048 + cb0 + bj * 128, pack8(acc[ai][bj][m][0], acc[ai][bj][m][1])); }
    }
};
struct EpiResid {
    static constexpr bool PERM = true, AFTER_DRAIN = false;
    float* X; const float* mod;
    DEV void operator()(const pg8::f32x4 (&acc)[2][2][4][2], const pg8::Unit& u, int wr, int wc, int fr, int fq) const {
        const int row0 = u.pm * 256 + wr * 64 + fr, cb0 = u.pn * 256 + wc * 32 + 8 * fq;
        const int b = u.pm / 9, mr = (u.pm - b * 9) == 0 ? 4 : b;
        const float* mp = mod + (size_t)mr * 12288;
        f32x4 gv[2][2];
#pragma unroll
        for (int bj = 0; bj < 2; ++bj)
#pragma unroll
            for (int n = 0; n < 2; ++n) gv[bj][n] = *(const f32x4*)(mp + cb0 + bj * 128 + 4 * n);
#pragma unroll
        for (int ai = 0; ai < 2; ++ai)
#pragma unroll
            for (int m = 0; m < 4; ++m) { const size_t row = row0 + ai * 128 + m * 16;
#pragma unroll
                for (int bj = 0; bj < 2; ++bj) { float* xp = X + row * 2048 + cb0 + bj * 128;
                    f32x4 x0 = *(const f32x4*)xp, x1 = *(const f32x4*)(xp + 4);
                    x0 += gv[bj][0] * acc[ai][bj][m][0]; x1 += gv[bj][1] * acc[ai][bj][m][1];
                    st16f(xp, x0); st16f(xp + 4, x1); } }
    }
};
struct EpiPartial {
    static constexpr bool PERM = true, AFTER_DRAIN = false;
    bf16_t* PP;
    DEV void operator()(const pg8::f32x4 (&acc)[2][2][4][2], const pg8::Unit& u, int wr, int wc, int fr, int fq) const {
        const int row0 = (u.pm / 9) * 256 + wr * 64 + fr, cb0 = u.pn * 256 + wc * 32 + 8 * fq;
#pragma unroll
        for (int ai = 0; ai < 2; ++ai)
#pragma unroll
            for (int m = 0; m < 4; ++m) { const size_t row = row0 + ai * 128 + m * 16;
#pragma unroll
                for (int bj = 0; bj < 2; ++bj) st16(PP + row * 2048 + cb0 + bj * 128, pack8(acc[ai][bj][m][0], acc[ai][bj][m][1])); }
    }
};
template <class Epi> DEV void run_gemm(const bf16_t* A, const bf16_t* Bt, int N, int K, int skip, const Epi& E, int rot = 0) {
    const int G_ = (int)gridDim.x; int c_ = (int)obid() - rot; if (c_ < 0) c_ += G_;
    pg8::Order S; S.init(skip ? 32 : 36, N, G_, c_, skip);
    pg8::Gemm g{A, Bt, MROWS, N, K, K};
    pg8::gemm_phase<Epi, pg8::Order, false>((PG8_LAS unsigned char*)shm, g, S, E, nullptr);
}
template <class Epi> DEV void run_gemm_ctxq(const bf16_t* A, const bf16_t* Bt, int N, int K, int q, const Epi& E) {
    const int G = (int)gridDim.x; int c = (int)obid() - 32 * q; if (c < 0) c += G;
    pg8::Order S; S.init(4, N, G, c, 2);
    pg8::Gemm g{A + (size_t)q * (K / 4), Bt + (size_t)q * (K / 4), MROWS, N, K / 4, K};
    pg8::gemm_phase<Epi, pg8::Order, false>((PG8_LAS unsigned char*)shm, g, S, E, nullptr);
}

DEV int mapcol(int mode, int n) {
    if (mode == 0) return n;
    if (mode == 1) return n < 5392 ? n : (n < 5632 ? -1 : n - 240);
    if (mode == 2) return 5904 + n;
    const int t = n >> 8, w = n & 255, half = w >> 7, j = w & 127;
    return half * (mode == 3 ? FFN : 512) + t * 128 + j;
}
DEV void tr_item(const float* W, int Nsrc, int K, bf16_t* WT, int nblk, int mode, int item, float* scr, int lane) {
    const int kb = item / nblk, nb = item - kb * nblk, k0 = 64 * kb, n0 = 64 * nb;
    const int n4 = (lane & 15) * 4, kr = lane >> 4;
    const int src = mapcol(mode, n0 + n4);
    const float* wp = W + (size_t)(k0 + kr) * Nsrc + src;
#pragma unroll 8
    for (int i = 0; i < 16; ++i) { f32x4 v = {0.f, 0.f, 0.f, 0.f};
        if (src >= 0) v = *(const f32x4*)(wp + (size_t)(4 * i) * Nsrc);
        float* d = scr + (4 * i + kr) * 65 + n4; d[0] = v[0]; d[1] = v[1]; d[2] = v[2]; d[3] = v[3]; }
    lds_wait();
    const int c = lane & 7;
#pragma unroll
    for (int j = 0; j < 8; ++j) { const int n = (lane >> 3) + 8 * j; const float* s = scr + (8 * c) * 65 + n;
        u32x4 o; o.x = pk2(s[0 * 65], s[1 * 65]); o.y = pk2(s[2 * 65], s[3 * 65]); o.z = pk2(s[4 * 65], s[5 * 65]); o.w = pk2(s[6 * 65], s[7 * 65]);
        st16(WT + (size_t)(n0 + n) * K + k0 + 8 * c, o); }
    lds_wait();
}
DEV void phase_convert(const KP& p, int l, int which, int chunk) {
    const int oz = opaque0();
    const int tid = otid(), wave = __builtin_amdgcn_readfirstlane(tid >> 6), lane = tid & 63;
    float* scr = (float*)shm + wave * (64 * 65);
    unsigned char* WB = wsp(p) + OFF_W;
    const int gw = obid() * 8 + wave, NGW = gridDim.x * 8;
    constexpr int I_WIN = 32 * (6144 / 64), I_WG = 32 * (8192 / 64), I_BA = 16 * 32, I_B5 = 8 * 32, I_WO = 32 * 32, I_FI = 32 * (11264 / 64), I_FO = 88 * 32, I_GL = 8 * 16;
    constexpr int I_LW = 8, I_LG = 16;
    constexpr int NIT = I_WIN + I_WG + I_BA + 3 * I_B5 + I_WO + I_FI + I_FO + I_GL + 4 * I_LW + I_LG;
    constexpr int N_A = I_WIN + I_WG + I_BA + 3 * I_B5 + I_WO, N_F = I_FI + I_FO;
    const int nloc = which == 0 ? NIT - N_F : (N_F + 127) / 128;
    for (int q = which == 0 ? gw : wave; q < nloc; q += which == 0 ? NGW : 8) {
        int it = which == 0 ? (q < N_A ? q : q + N_F) : N_A + chunk * ((N_F + 127) / 128) + q;
        if (which == 1 && it >= N_A + N_F) break;
        int r = it;
        if (r < I_WIN) { tr_item(p.in[oz + 8] + (size_t)l * 2048 * 14096, 14096, 2048, (bf16_t*)(WB + W_WIN), 6144 / 64, 1, r, scr, lane); continue; } r -= I_WIN;
        if (r < I_WG)  { tr_item(p.in[oz + 8] + (size_t)l * 2048 * 14096, 14096, 2048, (bf16_t*)(WB + W_WG), 8192 / 64, 2, r, scr, lane); continue; } r -= I_WG;
        if (r < I_BA)  { tr_item(p.in[oz + 36] + (size_t)l * 1024 * 2048, 2048, 1024, (bf16_t*)(WB + W_BA), 32, 0, r, scr, lane); continue; } r -= I_BA;
        if (r < I_B5)  { tr_item(p.in[oz + 37] + (size_t)l * 512 * 2048, 2048, 512, (bf16_t*)(WB + W_BR), 32, 0, r, scr, lane); continue; } r -= I_B5;
        if (r < I_B5)  { tr_item(p.in[oz + 38] + (size_t)l * 512 * 2048, 2048, 512, (bf16_t*)(WB + W_BM), 32, 0, r, scr, lane); continue; } r -= I_B5;
        if (r < I_B5)  { tr_item(p.in[oz + 39] + (size_t)l * 512 * 2048, 2048, 512, (bf16_t*)(WB + W_BS), 32, 0, r, scr, lane); continue; } r -= I_B5;
        if (r < I_WO)  { tr_item(p.in[oz + 40] + (size_t)l * 2048 * 2048, 2048, 2048, (bf16_t*)(WB + W_WO), 32, 0, r, scr, lane); continue; } r -= I_WO;
        if (r < I_FI)  { tr_item(p.in[oz + 41] + (size_t)l * 2048 * 11264, 11264, 2048, (bf16_t*)(WB + W_FI), 11264 / 64, 3, r, scr, lane); continue; } r -= I_FI;
        if (r < I_FO)  { tr_item(p.in[oz + 42] + (size_t)l * 5632 * 2048, 2048, 5632, (bf16_t*)(WB + W_FO), 32, 0, r, scr, lane); continue; } r -= I_FO;
        if (r < I_GL)  { tr_item(p.in[oz + 35] + (size_t)l * 512 * 1024, 1024, 512, (bf16_t*)(WB + W_GL), 16, 4, r, scr, lane); continue; } r -= I_GL;
        if (r < 4 * I_LW) { const int m = r >> 3;
            tr_item(p.in[oz + (m < 2 ? 14 : 16)] + (size_t)((l * 2 + (m & 1)) * 64) * 512, 512, 64, (bf16_t*)(WB + W_LW) + (size_t)m * 512 * 64, 8, 0, r & 7, scr, lane); continue; } r -= 4 * I_LW;
        tr_item(p.in[oz + 17] + (size_t)(l * 128) * 512, 512, 128, (bf16_t*)(WB + W_LW) + (size_t)4 * 512 * 64, 8, 0, r, scr, lane);
    }
}
DEV void phase_mod(const KP& p) {
    const int oz = opaque0();
    const int tid = otid(), wave = __builtin_amdgcn_readfirstlane(tid >> 6), lane = tid & 63;
    float* sc = (float*)shm; float* red = sc + 5 * 2048;
    __syncthreads();
    for (int i = tid; i < 5 * 2048; i += 512) { const int r = i >> 11, k = i & 2047; const float c = r < 4 ? p.in[oz + 1][r * 2048 + k] : p.in[oz + 3][k]; sc[i] = siluf(c); }
    __syncthreads();
    float* MOD = (float*)(wsp(p) + OFF_MOD);
    for (int it = obid(); it < 384; it += gridDim.x) {
        const int l = it / 192, cb = it - l * 192, col = cb * 64 + lane;
        const float* W = p.in[oz + 4] + (size_t)l * 2048 * 12288 + col;
        float a0 = 0.f, a1 = 0.f, a2 = 0.f, a3 = 0.f, a4 = 0.f;
#pragma unroll 8
        for (int k = wave * 256; k < wave * 256 + 256; ++k) { const float wv = W[(size_t)k * 12288];
            a0 += sc[k] * wv; a1 += sc[2048 + k] * wv; a2 += sc[4096 + k] * wv; a3 += sc[6144 + k] * wv; a4 += sc[8192 + k] * wv; }
        red[(wave * 5 + 0) * 64 + lane] = a0; red[(wave * 5 + 1) * 64 + lane] = a1; red[(wave * 5 + 2) * 64 + lane] = a2; red[(wave * 5 + 3) * 64 + lane] = a3; red[(wave * 5 + 4) * 64 + lane] = a4;
        __syncthreads();
        if (tid < 320) { const int r = tid >> 6; float s = 0.f;
#pragma unroll
            for (int w = 0; w < 8; ++w) s += red[(w * 5 + r) * 64 + lane];
            MOD[(size_t)(l * 5 + r) * 12288 + col] = s + p.in[oz + 5][l * 12288 + col]; }
        __syncthreads();
    }
}
DEV void phase_s5disc(const KP& p) {
    const int oz = opaque0();
    float* ABAR = (float*)(wsp(p) + OFF_ABAR); float* BBAR = (float*)(wsp(p) + OFF_BBAR);
    for (int gid = obid() * 512 + otid(); gid < 8192; gid += gridDim.x * 512) {
        const int ldg = gid >> 6;
        const float lre = p.in[oz + 27][gid], lim = p.in[oz + 28][gid], dt = expf(p.in[oz + 29][ldg]);
        const float mag = expf(lre * dt), ang = lim * dt, ar = mag * cosf(ang), ai = mag * sinf(ang);
        const float den = lre * lre + lim * lim;
        const float fr = ((ar - 1.f) * lre + ai * lim) / den, fi = (ai * lre - (ar - 1.f) * lim) / den;
        ABAR[gid * 2] = ar; ABAR[gid * 2 + 1] = ai;
#pragma unroll 4
        for (int c = 0; c < 16; ++c) { const float br = p.in[oz + 30][gid * 16 + c], bi = p.in[oz + 31][gid * 16 + c];
            BBAR[(gid * 16 + c) * 2] = fr * br - fi * bi; BBAR[(gid * 16 + c) * 2 + 1] = fr * bi + fi * br; }
    }
}
DEV void phase_norm(const KP& p, int l, int which, bool from_input, bool skipctx, int fold) {
    const int oz = opaque0();
    const int tid = otid(), wave = __builtin_amdgcn_readfirstlane(tid >> 6), lane = tid & 63;
    const int gw = obid() * 8 + wave, NGW = gridDim.x * 8;
    float* X = (float*)(wsp(p) + OFF_X); bf16_t* H = (bf16_t*)(wsp(p) + OFF_H);
    const float* MOD = (const float*)(wsp(p) + OFF_MOD);
    const float* gam = p.in[oz + (which ? 7 : 6)] + l * 2048;
    for (int row = gw; row < MROWS; row += NGW) {
        const int b = row / TPB, pp = row - b * TPB, mr = pp < 256 ? 4 : b;
        if (skipctx && pp < 256) continue;
        const float* src = from_input ? (pp < 256 ? p.in[oz + 2] + ((size_t)b * 256 + pp) * 2048 : p.in[oz + 0] + ((size_t)b * 2048 + (pp - 256)) * 2048) : X + (size_t)row * 2048;
        f32x4 v[8]; float ss = 0.f;
        const bool dofold = fold >= 0 && pp < 256;
#pragma unroll
        for (int j = 0; j < 8; ++j) { v[j] = ((const f32x4*)src)[lane + 64 * j];
            if (dofold) { const int c4 = lane + 64 * j; const bf16_t* pp_ = (const bf16_t*)(wsp(p) + OFF_PART) + ((size_t)(b * 256 + pp)) * 2048 + c4 * 4;
                f32x4 sacc = {0.f, 0.f, 0.f, 0.f};
#pragma unroll
                for (int q = 0; q < 4; ++q) { const u32x2 t = *(const u32x2*)(pp_ + (size_t)q * 1024 * 2048);
                    sacc[0] += __uint_as_float(t.x << 16); sacc[1] += __uint_as_float(t.x & 0xffff0000u); sacc[2] += __uint_as_float(t.y << 16); sacc[3] += __uint_as_float(t.y & 0xffff0000u); }
                const f32x4 gv = ((const f32x4*)(MOD + (size_t)((fold >> 3) * 5 + 4) * 12288 + (fold & 7) * 2048))[c4];
                v[j] += gv * sacc; ((f32x4*)(X + (size_t)row * 2048))[c4] = v[j]; }
            ss += v[j][0] * v[j][0] + v[j][1] * v[j][1] + v[j][2] * v[j][2] + v[j][3] * v[j][3]; }
        ss = wsum(ss);
        const float rs = 1.f / sqrtf(ss * (1.f / 2048.f) + 1e-6f);
        const float* shp = MOD + (size_t)(l * 5 + mr) * 12288 + (which ? 3 : 0) * 2048; const float* scp = shp + 2048;
#pragma unroll
        for (int j = 0; j < 8; ++j) { const int c4 = lane + 64 * j;
            if (from_input) ((f32x4*)(X + (size_t)row * 2048))[c4] = v[j];
            const f32x4 g = ((const f32x4*)gam)[c4], sh = ((const f32x4*)shp)[c4], sc = ((const f32x4*)scp)[c4];
            const f32x4 y = v[j] * rs * g; const f32x4 h = y * (sc + 1.f) + sh;
            u32x2 o; o.x = pk2(h[0], h[1]); o.y = pk2(h[2], h[3]); ((u32x2*)(H + (size_t)row * 2048))[c4] = o; }
    }
}
DEV void phase_final(const KP& p) {
    const int oz = opaque0();
    const int tid = otid(), wave = __builtin_amdgcn_readfirstlane(tid >> 6), lane = tid & 63;
    const int gw = obid() * 8 + wave, NGW = gridDim.x * 8;
    const float* X = (const float*)(wsp(p) + OFF_X); const float* gam = p.in[oz + 43];
    for (int r = gw; r < 8192; r += NGW) {
        const int b = r >> 11, t = r & 2047; const float* src = X + ((size_t)b * TPB + 256 + t) * 2048;
        f32x4 v[8]; float ss = 0.f;
#pragma unroll
        for (int j = 0; j < 8; ++j) { v[j] = ((const f32x4*)src)[lane + 64 * j]; ss += v[j][0] * v[j][0] + v[j][1] * v[j][1] + v[j][2] * v[j][2] + v[j][3] * v[j][3]; }
        ss = wsum(ss);
        const float rs = 1.f / sqrtf(ss * (1.f / 2048.f) + 1e-6f);
#pragma unroll
        for (int j = 0; j < 8; ++j) { const int c4 = lane + 64 * j; ((f32x4*)(p.out + (size_t)r * 2048))[c4] = v[j] * rs * ((const f32x4*)gam)[c4]; }
    }
}
DEV void phase_attnprep(const KP& p, int l) {
    const int oz = opaque0();
    const int tid = otid(), wave = __builtin_amdgcn_readfirstlane(tid >> 6), lane = tid & 63;
    const int gw = obid() * 8 + wave, NGW = gridDim.x * 8;
    bf16_t* ZA = (bf16_t*)(wsp(p) + OFF_ZA);
    const float* qg = p.in[oz + 10] + l * 128; const float* kg = p.in[oz + 11] + l * 128;
    const float qg0 = qg[lane], qg1 = qg[64 + lane], kg0 = kg[lane], kg1 = kg[64 + lane];
    const float invf = exp2f(-(float)(lane & 31) * (13.287712379549449f / 32.f));
    for (int row = gw; row < MROWS; row += NGW) {
        bf16_t* z = ZA + (size_t)row * LD_ZA; const int pp = row % TPB; const bool lat = pp >= 256; const int t = pp - 256;
        float cr = 1.f, sr = 0.f, cc = 1.f, scn = 0.f;
        if (lat) { const float a1 = (float)(t >> 6) * invf, a2 = (float)(t & 63) * invf; cr = __cosf(a1); sr = __sinf(a1); cc = __cosf(a2); scn = __sinf(a2); }
#pragma unroll
        for (int j = 0; j < 10; ++j) {
            const float v0 = bf2f(z[j * 128 + lane]), v1 = bf2f(z[j * 128 + 64 + lane]);
            const float ss = wsum(v0 * v0 + v1 * v1); const float rs = 1.f / sqrtf(ss * (1.f / 128.f) + 1e-6f);
            float y0 = v0 * rs * (j < 8 ? qg0 : kg0), y1 = v1 * rs * (j < 8 ? qg1 : kg1);
            if (lat) { const float p0 = __shfl_xor(y0, 32), p1 = __shfl_xor(y1, 32);
                if (lane < 32) { y0 = y0 * cr - p0 * sr; y1 = y1 * cc - p1 * scn; } else { y0 = p0 * sr + y0 * cr; y1 = p1 * scn + y1 * cc; } }
            z[j * 128 + lane] = f2bf(y0); z[j * 128 + 64 + lane] = f2bf(y1);
        }
    }
}
DEV float shiftz(const float* ZF, int row, int col, float mu) {
    const int pp = row % TPB; const float* zp = ZF + (size_t)row * LD_ZF + col; const float z = zp[0];
    const float zl = (pp != 0 && pp != 256) ? zp[-LD_ZF] : 0.f, zr = (pp != 255 && pp != 2303) ? zp[LD_ZF] : 0.f;
    return z + mu * (0.5f * (zl + zr) - z);
}
DEV void phase_rwkvprep(const KP& p, int l) {
    const int oz = opaque0();
    const int tid = otid(), wave = __builtin_amdgcn_readfirstlane(tid >> 6), lane = tid & 63, j = tid;
    bf16_t* Xs = (bf16_t*)shm;
    float* outs = (float*)(shm + 16 * 264 * 2);
    const float* ZF = (const float*)(wsp(p) + OFF_ZF);
    float* RW = (float*)(wsp(p) + OFF_RW); float* C12 = (float*)(wsp(p) + OFF_C12);
    const bf16_t* LW = (const bf16_t*)(wsp(p) + OFF_W + W_LW);
    const float* mu = p.in[oz + 12] + l * 1792;
    const float w00 = p.in[oz + 13][(l * 2 + 0) * 512 + j], w01 = p.in[oz + 13][(l * 2 + 1) * 512 + j], a00 = p.in[oz + 15][(l * 2 + 0) * 512 + j], a01 = p.in[oz + 15][(l * 2 + 1) * 512 + j];
    const float kkc = p.in[oz + 18][l * 512 + j], kac = p.in[oz + 19][l * 512 + j], rkc = p.in[oz + 20][l * 512 + j], mu_r = mu[j], mu_k = mu[512 + j], mu_v = mu[1024 + j];
    __syncthreads();
    for (int e = tid; e < 8 * 264; e += 512) Xs[8 * 264 + e] = 0;
    for (int it = obid(); it < 1152; it += gridDim.x) {
        const int row0 = it * 8;
        __syncthreads();
        for (int e = tid; e < 8 * 256; e += 512) { const int t = e >> 8, cc = e & 255; const float z = shiftz(ZF, row0 + t, 1536 + cc, mu[1536 + cc]);
            Xs[t * 264 + cc] = f2bf(cc < 64 ? tanhf(z) : (cc < 128 ? z : sigm(z))); }
        __syncthreads();
        { const int lr = lane & 15, lq4 = lane >> 4;
#pragma unroll 1
            for (int t4 = 0; t4 < 4; ++t4) { const int col = wave * 64 + t4 * 16 + lr;
#pragma unroll
                for (int m = 0; m < 5; ++m) { const int K = m < 4 ? 64 : 128, xoff = m < 2 ? 0 : (m < 4 ? 64 : 128);
                    const bf16_t* WT = LW + (size_t)(m < 4 ? m * 512 * 64 : 4 * 512 * 64) + (size_t)col * K + 8 * lq4;
                    pg8::f32x4 acc = {0.f, 0.f, 0.f, 0.f};
#pragma unroll
                    for (int ks = 0; ks < K / 32; ++ks) { const bf16x8 a = *(const bf16x8*)(Xs + lr * 264 + xoff + 32 * ks + 8 * lq4), bq = *(const bf16x8*)(WT + 32 * ks);
                        acc = __builtin_amdgcn_mfma_f32_16x16x32_bf16(a, bq, acc, 0, 0, 0); }
                    if (lq4 < 2) {
#pragma unroll
                        for (int i = 0; i < 4; ++i) outs[(m * 8 + 4 * lq4 + i) * 512 + col] = acc[i]; } } } }
        __syncthreads();
        float zr[10], zk[10], zv[10];
        { const int pp0 = row0 % TPB; const bool hasL = pp0 != 0 && pp0 != 256, hasR = (pp0 + 7) != 255 && (pp0 + 7) != 2303;
#pragma unroll
            for (int i = 0; i < 10; ++i) { const bool ok = i == 0 ? hasL : (i == 9 ? hasR : true); const float* zp = ZF + (size_t)(row0 - 1 + i) * LD_ZF + j;
                zr[i] = ok ? zp[0] : 0.f; zk[i] = ok ? zp[512] : 0.f; zv[i] = ok ? zp[1024] : 0.f; } }
#pragma unroll
        for (int t = 0; t < 8; ++t) {
            const int row = row0 + t; const size_t o = (size_t)row * 512 + j;
            const float r = zr[t + 1] + mu_r * (0.5f * (zr[t] + zr[t + 2]) - zr[t + 1]), k = zk[t + 1] + mu_k * (0.5f * (zk[t] + zk[t + 2]) - zk[t + 1]), v = zv[t + 1] + mu_v * (0.5f * (zv[t] + zv[t + 2]) - zv[t + 1]);
            const float kkr = k * kkc; const float ss = wsum(kkr * kkr); const float kk = kkr * (1.f / sqrtf(ss + 1e-12f));
            RW[0 * SZ_RW + o] = r; RW[1 * SZ_RW + o] = v; RW[2 * SZ_RW + o] = kk; RW[9 * SZ_RW + o] = outs[(4 * 8 + t) * 512 + j];
#pragma unroll
            for (int d = 0; d < 2; ++d) {
                const float wpre = (d ? w01 : w00) + outs[((d ? 1 : 0) * 8 + t) * 512 + j];
                const float w = __expf(-0.6065306597126334f * sigm(wpre));
                const float a = sigm((d ? a01 : a00) + outs[((d ? 3 : 2) * 8 + t) * 512 + j]);
                const float km = k * (1.f + (a - 1.f) * kac), bb = a * kk;
                const float c1 = wsum(bb * r), c2 = wsum(r * km * (1.f + rkc));
                RW[(3 + d) * SZ_RW + o] = w; RW[(5 + d) * SZ_RW + o] = bb; RW[(7 + d) * SZ_RW + o] = km;
                if (lane == 0) { float* cp = C12 + (((size_t)d * MROWS + row) * 8 + wave) * 2; cp[0] = c1; cp[1] = c2; }
            }
        }
    }
}

template <int CTRL> DEV float dpp_f(float v) { return __builtin_bit_cast(float, __builtin_amdgcn_update_dpp(0, __builtin_bit_cast(int, v), CTRL, 0xF, 0xF, true)); }
#define dpp_f(v, ctrl) dpp_f<ctrl>(v)
DEV void rwkv_scan(const KP& p, int sid, int half) {
    const int oz = opaque0();
    const int b = sid >> 4, h = (sid >> 1) & 7, d = sid & 1;
    const int tid = otid(), wave = __builtin_amdgcn_readfirstlane(tid >> 6), lane = tid & 63, rp = lane >> 4, kq = lane & 15;
    const int row0 = half * 32 + wave * 4 + rp;
    float* buf = (float*)shm;
    float* olds = buf + 16 * 400;
    const float* RW = (const float*)(wsp(p) + OFF_RW);
    const float* C12 = (const float*)(wsp(p) + OFF_C12) + (size_t)d * MROWS * 16;
    float* ORW = (float*)(wsp(p) + OFF_SC) + (size_t)d * SZ_RW;
    const int lstep = tid >> 5, lq = tid & 31;
    f32x4 S0 = {0.f, 0.f, 0.f, 0.f};
    f32x4 st0, st1, st2; f32x2 cst = {0.f, 0.f};
#define RWK_SRC(e_, row_) (RW + (size_t)((((e_) >> 4) == 0) ? 3 + d : (((e_) >> 4) == 1) ? 2 : (((e_) >> 4) == 2) ? 5 + d : (((e_) >> 4) == 3) ? 7 + d : (((e_) >> 4) == 4) ? 0 : 1) * SZ_RW + (size_t)(row_) * 512 + h * 64 + ((e_) & 15) * 4)
#define RWK_ISSUE(chunk_) do { const int row_ = b * TPB + seqpos((chunk_) * 16 + lstep, d); \
        st0 = *(const f32x4*)RWK_SRC(lq, row_); st1 = *(const f32x4*)RWK_SRC(lq + 32, row_); st2 = *(const f32x4*)RWK_SRC(lq + 64, row_); \
        if (lq == 0) cst = *(const f32x2*)(C12 + ((size_t)row_ * 8 + h) * 2); } while (0)
#define RWK_COMMIT() do { float* bp_ = buf + lstep * 400; *(f32x4*)(bp_ + lq * 4) = st0; *(f32x4*)(bp_ + (lq + 32) * 4) = st1; *(f32x4*)(bp_ + (lq + 64) * 4) = st2; \
        if (lq == 0) { bp_[384] = cst[0]; bp_[385] = cst[1]; } } while (0)
    __syncthreads();
    RWK_ISSUE(0); RWK_COMMIT();
    __syncthreads();
    const float* __restrict__ rbuf = buf;
#pragma unroll 1
    for (int c = 0; c < 144; ++c) {
        if (c + 1 < 144) RWK_ISSUE(c + 1);
        {
        float osel0 = 0.f;
#define RW_LOAD(st_, W, K, B, M, R, V, C) do { const float* sp_ = rbuf + (st_) * 400 + kq * 4; W = *(const f32x4*)(sp_); K = *(const f32x4*)(sp_ + 64); B = *(const f32x4*)(sp_ + 128); \
            M = *(const f32x4*)(sp_ + 192); R = *(const f32x4*)(sp_ + 256); V = rbuf[(st_) * 400 + 320 + row0]; C = *(const f32x2*)(rbuf + (st_) * 400 + 384); } while (0)
#define RW_STEP(st_, W, K, B, M, R, V, C) do { \
            const f32x4 p0 = S0 * K, wr = W * R; const f32x4 q0 = S0 * wr; \
            float sa0 = (p0[0] + p0[1]) + (p0[2] + p0[3]); \
            float so0 = (q0[0] + q0[1]) + (q0[2] + q0[3]); \
            const f32x4 t0 = M * V; \
            sa0 += dpp_f(sa0, 0xB1); sa0 += dpp_f(sa0, 0x4E); sa0 += dpp_f(sa0, 0x141); sa0 += dpp_f(sa0, 0x140); \
            S0 = S0 * W + (t0 - B * sa0); \
            so0 += dpp_f(so0, 0xB1); so0 += dpp_f(so0, 0x4E); so0 += dpp_f(so0, 0x141); so0 += dpp_f(so0, 0x140); \
            const float o0 = so0 - sa0 * C[0] + V * C[1]; \
            osel0 = (kq == (st_)) ? o0 : osel0; } while (0)
        f32x4 aw, ak, ab, am, ar, bw, bk, bb, bm, br; f32x2 ac, bc; float av, bv;
        RW_LOAD(0, aw, ak, ab, am, ar, av, ac);
#pragma unroll 2
        for (int s2 = 0; s2 < 16; s2 += 2) {
            RW_LOAD(s2 + 1, bw, bk, bb, bm, br, bv, bc);
            __builtin_amdgcn_sched_barrier(0);
            RW_STEP(s2, aw, ak, ab, am, ar, av, ac);
            if (s2 + 2 < 16) RW_LOAD(s2 + 2, aw, ak, ab, am, ar, av, ac);
            __builtin_amdgcn_sched_barrier(0);
            RW_STEP(s2 + 1, bw, bk, bb, bm, br, bv, bc);
        }
#undef RW_LOAD
#undef RW_STEP
        olds[kq * 64 + row0] = osel0;
        }
        __syncthreads();
        if ((lq >> 4) == half) { const int row_ = b * TPB + seqpos(c * 16 + lstep, d); *(f32x2*)(ORW + (size_t)row_ * 512 + h * 64 + lq * 2) = *(const f32x2*)(olds + lstep * 64 + lq * 2); }
        if (c + 1 < 144) RWK_COMMIT();
        __syncthreads();
    }
#undef RWK_SRC
#undef RWK_ISSUE
#undef RWK_COMMIT
}

DEV f32x16 mfma32(bf16x8 a, bf16x8 b, f32x16 c) { return __builtin_amdgcn_mfma_f32_32x32x16_bf16(a, b, c, 0, 0, 0); }
DEV void mlstm_scan(const KP& p, int l, int mid) {
    const int oz = opaque0();
    const int b = mid >> 4, h = (mid >> 2) & 3, d = (mid >> 1) & 1, vbase = (mid & 1) * 64;
    const int tid = otid(), wave = __builtin_amdgcn_readfirstlane(tid >> 6), lane = tid & 63, r32 = lane & 31, hi = lane >> 5;
    bf16_t* Qc = (bf16_t*)shm;
    bf16_t* Kc = Qc + 64 * 136;
    bf16_t* KcT = Kc + 64 * 136;
    bf16_t* VT = KcT + 128 * 72;
    bf16_t* VsT = VT + 64 * 72;
    bf16_t* Sm = VsT + 64 * 72;
    bf16_t* Cb = Sm + 64 * 72;
    float* fl = (float*)(Cb + 64 * 136);
    float* gS = fl, *MtS = fl + 64, *srcS = fl + 128, *winS = fl + 192, *emtS = fl + 256, *nvec = fl + 320, *rsp = fl + 448, *nqp = fl + 576, *dnw = fl + 1088, *cw = fl + 1344;
    bf16_t* Ql = (bf16_t*)(fl + 2112);
    bf16_t* Kl = Ql + 64 * 136;
    const float* ZF = (const float*)(wsp(p) + OFF_ZF);
    float* HM = (float*)(wsp(p) + OFF_SC) + (size_t)(2 + d) * SZ_RW;
    const float ib = p.in[oz + 24][l * 8 + d * 4 + h], fb = p.in[oz + 25][l * 8 + d * 4 + h];
    __syncthreads();
    for (int e = tid; e < 64 * 136; e += 512) Cb[e] = 0;
    if (tid < 128) nvec[tid] = 0.f;
    for (int e = tid; e < 768; e += 512) { const int jj = e >> 8, c = e & 255; cw[e] = p.in[oz + 23][(size_t)(l * 3 + jj) * 1024 + (c < 128 ? h * 128 + c : 512 + h * 128 + (c - 128))]; }
    __syncthreads();
    f32x16 accC;
#pragma unroll
    for (int r = 0; r < 16; ++r) accC[r] = 0.f;
    float m = 0.f;
    const int ti = tid >> 3, cg8 = tid & 7;
#pragma unroll 1
    for (int c = 0; c < 36; ++c) {
        const int rowi = b * TPB + seqpos(64 * c + lane, d);
        const float igv = ZF[(size_t)rowi * LD_ZF + ZF_MLG + d * 4 + h] + ib, fgv = ZF[(size_t)rowi * LD_ZF + ZF_MLG + 8 + d * 4 + h] + fb;
        const float lf = fgv > 0.f ? -log1pf(__expf(-fgv)) : fgv - log1pf(__expf(fgv));
        float cum = lf;
#pragma unroll
        for (int o = 1; o < 64; o <<= 1) { const float t = __shfl_up(cum, o); if (lane >= o) cum += t; }
        const float g = igv - cum; float pm = g;
#pragma unroll
        for (int o = 1; o < 64; o <<= 1) { const float t = __shfl_up(pm, o); if (lane >= o) pm = fmaxf(pm, t); }
        const float Mt = fmaxf(pm, m), M63 = __shfl(Mt, 63), total = __shfl(cum, 63);
        const float src = __expf(g - M63), decay = __expf(m - M63), win = __expf(m - Mt), emt = __expf(-(cum + Mt));
        if (wave == 0) { gS[lane] = g; MtS[lane] = Mt; srcS[lane] = src; winS[lane] = win; emtS[lane] = emt; }
        const float m_next = total + M63;
        {
            const int pT = seqpos(64 * c + ti, d); const size_t rowT = (size_t)b * TPB + pT;
            const bool hasL = (pT != 0 && pT != 256), hasR = (pT != 255 && pT != 2303);
            const float* zc = ZF + rowT * LD_ZF + ZF_ML;
            const float srcT = __shfl(src, ti);
#pragma unroll
            for (int part = 0; part < 2; ++part) {
                const float* base = zc + part * 512 + h * 128 + 16 * cg8;
#pragma unroll
                for (int v4 = 0; v4 < 4; ++v4) {
                    const f32x4 zm = *(const f32x4*)(base + 4 * v4);
                    f32x4 zl = {0.f, 0.f, 0.f, 0.f}, zr = {0.f, 0.f, 0.f, 0.f};
                    if (hasL) zl = *(const f32x4*)(base - LD_ZF + 4 * v4);
                    if (hasR) zr = *(const f32x4*)(base + LD_ZF + 4 * v4);
                    const int cc = part * 128 + 16 * cg8 + 4 * v4;
                    const f32x4 w0 = *(const f32x4*)(cw + cc), w1 = *(const f32x4*)(cw + 256 + cc), w2 = *(const f32x4*)(cw + 512 + cc);
                    f32x4 val = zl * w0 + zm * w1 + zr * w2;
#pragma unroll
                    for (int i = 0; i < 4; ++i) val[i] = siluf(val[i]) * (part ? 0.08838834764831845f : 1.f);
                    u32x2 o; o.x = pk2(val[0], val[1]); o.y = pk2(val[2], val[3]);
                    const int ch = 16 * cg8 + 4 * v4;
                    if (part == 0) { *(u32x2*)(Qc + ti * 136 + ch) = o; }
                    else { *(u32x2*)(Kc + ti * 136 + ch) = o;
                        KcT[(ch + 0) * 72 + ti] = (bf16_t)(o.x & 0xffffu); KcT[(ch + 1) * 72 + ti] = (bf16_t)(o.x >> 16); KcT[(ch + 2) * 72 + ti] = (bf16_t)(o.y & 0xffffu); KcT[(ch + 3) * 72 + ti] = (bf16_t)(o.y >> 16); }
                }
            }
            const float* vsrc = zc + 1024 + h * 128 + vbase + 8 * cg8;
#pragma unroll
            for (int v4 = 0; v4 < 2; ++v4) { const f32x4 vv = *(const f32x4*)(vsrc + 4 * v4);
#pragma unroll
                for (int i = 0; i < 4; ++i) { const int vc = 8 * cg8 + 4 * v4 + i; VT[vc * 72 + ti] = f2bf(vv[i]); VsT[vc * 72 + ti] = f2bf(vv[i] * srcT); } }
        }
        __syncthreads();
        f32x16 acc2;
#pragma unroll
        for (int r = 0; r < 16; ++r) acc2[r] = 0.f;
        const int w4 = wave - 4, tt2 = (w4 >> 1) & 1, vt = w4 & 1;
        if (wave < 4) {
            const int st = wave & 1, tt = wave >> 1;
            f32x16 acc;
#pragma unroll
            for (int r = 0; r < 16; ++r) acc[r] = 0.f;
            if (!(st == 1 && tt == 0)) {
#pragma unroll
                for (int kk = 0; kk < 8; ++kk) { const int ao = (32 * st + r32) * 136 + 16 * kk + 8 * hi, bo = (32 * tt + r32) * 136 + 16 * kk + 8 * hi;
                    const bf16x8 a = *(const bf16x8*)(Kc + ao), bq = *(const bf16x8*)(Qc + bo);
                    acc = mfma32(a, bq, acc); }
            }
            const int t = 32 * tt + r32; const float Mtt = MtS[t]; float psum = 0.f;
#pragma unroll
            for (int r4 = 0; r4 < 4; ++r4) { float vals[4];
#pragma unroll
                for (int i = 0; i < 4; ++i) { const int r = r4 * 4 + i, s = 32 * st + crow16(r, hi); const float dv = (s <= t) ? __expf(gS[s] - Mtt) : 0.f; vals[i] = acc[r] * dv; psum += vals[i]; }
                u32x2 o; o.x = pk2(vals[0], vals[1]); o.y = pk2(vals[2], vals[3]); *(u32x2*)(Sm + t * 72 + 32 * st + 8 * r4 + 4 * hi) = o; }
            psum += __shfl_xor(psum, 32);
            if (hi == 0) rsp[st * 64 + t] = psum;
        } else {
#pragma unroll
            for (int kk = 0; kk < 8; ++kk) { const bf16x8 a = *(const bf16x8*)(Qc + (32 * tt2 + r32) * 136 + 16 * kk + 8 * hi), bb = *(const bf16x8*)(Cb + (32 * vt + r32) * 136 + 16 * kk + 8 * hi);
                acc2 = mfma32(a, bb, acc2); }
        }
        { const int t = tid & 63, part = tid >> 6; float s = 0.f;
#pragma unroll
            for (int k = 0; k < 16; ++k) s += nvec[part * 16 + k] * bf2f(Qc[t * 136 + part * 16 + k]);
            nqp[part * 64 + t] = s; }
        __syncthreads();
        if (wave >= 4) {
            float den = rsp[lane] + rsp[64 + lane]; float nq = 0.f;
#pragma unroll
            for (int part = 0; part < 8; ++part) nq += nqp[part * 64 + lane];
            den += winS[lane] * nq;
            float* my = dnw + w4 * 64; my[lane] = 1.f / fmaxf(fabsf(den), emtS[lane]); lds_wait();
#pragma unroll
            for (int r = 0; r < 16; ++r) acc2[r] *= winS[32 * tt2 + crow16(r, hi)];
#pragma unroll
            for (int kk = 0; kk < 4; ++kk) { const bf16x8 a = *(const bf16x8*)(Sm + (32 * tt2 + r32) * 72 + 16 * kk + 8 * hi), bb = *(const bf16x8*)(VT + (32 * vt + r32) * 72 + 16 * kk + 8 * hi);
                acc2 = mfma32(a, bb, acc2); }
#pragma unroll
            for (int r = 0; r < 16; ++r) { const int t = 32 * tt2 + crow16(r, hi); const int pT = seqpos(64 * c + t, d);
                HM[((size_t)b * TPB + pT) * 512 + h * 128 + vbase + 32 * vt + r32] = acc2[r] * my[t]; }
        } else if (wave < 2) {
            float s = 0.f;
#pragma unroll 8
            for (int si = 0; si < 64; ++si) s += srcS[si] * bf2f(KcT[tid * 72 + si]);
            nvec[tid] = decay * nvec[tid] + s;
        }
        { const int kt = wave & 3, vt2 = wave >> 2;
#pragma unroll
            for (int r = 0; r < 16; ++r) accC[r] *= decay;
#pragma unroll
            for (int kk = 0; kk < 4; ++kk) { const bf16x8 a = *(const bf16x8*)(KcT + (32 * kt + r32) * 72 + 16 * kk + 8 * hi), bb = *(const bf16x8*)(VsT + (32 * vt2 + r32) * 72 + 16 * kk + 8 * hi);
                accC = mfma32(a, bb, accC); }
#pragma unroll
            for (int r4 = 0; r4 < 4; ++r4) { u32x2 o; o.x = pk2(accC[r4 * 4 + 0], accC[r4 * 4 + 1]); o.y = pk2(accC[r4 * 4 + 2], accC[r4 * 4 + 3]);
                *(u32x2*)(Cb + (32 * vt2 + r32) * 136 + 32 * kt + 8 * r4 + 4 * hi) = o; } }
        m = m_next;
        __syncthreads();
    }
}

DEV void s5_scan(const KP& p, int l, int sid) {
    const int oz = opaque0();
    const int b = sid >> 6, g = (sid >> 1) & 31, d = sid & 1;
    const int tid = otid(), wave = __builtin_amdgcn_readfirstlane(tid >> 6), lane = tid & 63;
    float* CRs = (float*)shm; float* CIs = CRs + 1024; float* Fs = CIs + 1024;
    float* us = Fs + 1024 + wave * (256 + 2 * 16 * 65); float* xsr = us + 256; float* xsi = xsr + 16 * 65;
    const int ldg = (l * 2 + d) * 32 + g, gid = ldg * 64 + lane;
    const float* ABAR = (const float*)(wsp(p) + OFF_ABAR); const float* BBAR = (const float*)(wsp(p) + OFF_BBAR);
    const float* ZF = (const float*)(wsp(p) + OFF_ZF);
    float* YS = (float*)(wsp(p) + OFF_SC) + (size_t)(4 + d) * SZ_RW;
    const float ar = ABAR[gid * 2], ai = ABAR[gid * 2 + 1];
    const int lt = lane & 15, lq = lane >> 4;
    bf16x8 B1[8], B2[8];
#pragma unroll
    for (int j = 0; j < 8; ++j) { const float* bp = BBAR + ((size_t)(ldg * 64 + 16 * (j & 3) + lt) * 16 + 8 * (lq & 1)) * 2 + (j >> 2);
        float bv[8];
#pragma unroll
        for (int i = 0; i < 8; ++i) bv[i] = bp[2 * i];
        u32x4 hi; hi.x = pk2(bv[0], bv[1]); hi.y = pk2(bv[2], bv[3]); hi.z = pk2(bv[4], bv[5]); hi.w = pk2(bv[6], bv[7]);
        u32x4 lo; lo.x = pk2(bv[0] - __uint_as_float(hi.x << 16), bv[1] - __uint_as_float(hi.x & 0xffff0000u)); lo.y = pk2(bv[2] - __uint_as_float(hi.y << 16), bv[3] - __uint_as_float(hi.y & 0xffff0000u));
        lo.z = pk2(bv[4] - __uint_as_float(hi.z << 16), bv[5] - __uint_as_float(hi.z & 0xffff0000u)); lo.w = pk2(bv[6] - __uint_as_float(hi.w << 16), bv[7] - __uint_as_float(hi.w & 0xffff0000u));
        if (lq >= 2) lo = (u32x4){0u, 0u, 0u, 0u};
        B1[j] = __builtin_bit_cast(bf16x8, hi); B2[j] = __builtin_bit_cast(bf16x8, lo); }
    float* buf = xsr;
    __syncthreads();
    for (int e = tid; e < 1024; e += 512) { const int c = e >> 6, pp = e & 63; CRs[pp * 16 + c] = p.in[oz + 32][(size_t)ldg * 1024 + e]; CIs[pp * 16 + c] = -p.in[oz + 33][(size_t)ldg * 1024 + e]; }
    const int s0w = wave * 288, lstep = lane >> 2, lpart = lane & 3;
#define S5_LOADU(sub_) (*(const f32x4*)(ZF + ((size_t)b * TPB + seqpos(s0w + (sub_) * 16 + lstep, d)) * LD_ZF + ZF_S5 + g * 16 + lpart * 4))
#define S5_BU() do { const f32x4 ua_ = *(const f32x4*)(us + lt * 16 + 8 * (lq & 1)), ub_ = *(const f32x4*)(us + lt * 16 + 8 * (lq & 1) + 4); \
        u32x4 hi_; hi_.x = pk2(ua_[0], ua_[1]); hi_.y = pk2(ua_[2], ua_[3]); hi_.z = pk2(ub_[0], ub_[1]); hi_.w = pk2(ub_[2], ub_[3]); \
        u32x4 lo_; lo_.x = pk2(ua_[0] - __uint_as_float(hi_.x << 16), ua_[1] - __uint_as_float(hi_.x & 0xffff0000u)); lo_.y = pk2(ua_[2] - __uint_as_float(hi_.y << 16), ua_[3] - __uint_as_float(hi_.y & 0xffff0000u)); \
        lo_.z = pk2(ub_[0] - __uint_as_float(hi_.z << 16), ub_[1] - __uint_as_float(hi_.z & 0xffff0000u)); lo_.w = pk2(ub_[2] - __uint_as_float(hi_.w << 16), ub_[3] - __uint_as_float(hi_.w & 0xffff0000u)); \
        const bf16x8 A1_ = __builtin_bit_cast(bf16x8, lq < 2 ? hi_ : lo_), A2_ = __builtin_bit_cast(bf16x8, lq < 2 ? hi_ : (u32x4){0u, 0u, 0u, 0u}); \
        _Pragma("unroll") for (int j_ = 0; j_ < 8; ++j_) { pg8::f32x4 d_ = {0.f, 0.f, 0.f, 0.f}; \
            d_ = __builtin_amdgcn_mfma_f32_16x16x32_bf16(A1_, B1[j_], d_, 0, 0, 0); d_ = __builtin_amdgcn_mfma_f32_16x16x32_bf16(A2_, B2[j_], d_, 0, 0, 0); \
            _Pragma("unroll") for (int r_ = 0; r_ < 4; ++r_) buf[(4 * lq + r_) * 130 + 16 * j_ + lt] = d_[r_]; } \
        lds_wait(); } while (0)
#define S5_STEP(step_) do { const float bre_ = buf[(step_) * 130 + lane], bim_ = buf[(step_) * 130 + 64 + lane]; \
        const float nxr_ = ar * xr - ai * xi + bre_, nxi_ = ar * xi + ai * xr + bim_; xr = nxr_; xi = nxi_; } while (0)
    float xr = 0.f, xi = 0.f;
    f32x4 un = S5_LOADU(0);
#pragma unroll 1
    for (int sub = 0; sub < 18; ++sub) {
        lds_wait(); *(f32x4*)(us + lane * 4) = un; lds_wait();
        if (sub + 1 < 18) un = S5_LOADU(sub + 1);
        S5_BU();
#pragma unroll 4
        for (int step = 0; step < 16; ++step) S5_STEP(step);
    }
    Fs[(wave * 64 + lane) * 2] = xr; Fs[(wave * 64 + lane) * 2 + 1] = xi;
    __syncthreads();
    { float pr = ar, pi = ai, qr = 0.f, qi = 0.f;
#pragma unroll
        for (int i = 0; i < 8; ++i) { const float nr = pr * pr - pi * pi, ni = 2.f * pr * pi; pr = nr; pi = ni; if (i == 4) { qr = pr; qi = pi; } }
        const float er = pr * qr - pi * qi, ei = pr * qi + pi * qr;
        xr = 0.f; xi = 0.f;
        for (int w = 0; w < wave; ++w) { const float fr = Fs[(w * 64 + lane) * 2], fi = Fs[(w * 64 + lane) * 2 + 1]; const float nr = er * xr - ei * xi + fr, ni = er * xi + ei * xr + fi; xr = nr; xi = ni; } }
    float cbr[16], cbi[16];
#pragma unroll
    for (int ks = 0; ks < 16; ++ks) { cbr[ks] = CRs[(4 * ks + (lane >> 4)) * 16 + (lane & 15)]; cbi[ks] = CIs[(4 * ks + (lane >> 4)) * 16 + (lane & 15)]; }
    un = S5_LOADU(0);
#pragma unroll 1
    for (int sub = 0; sub < 18; ++sub) {
        lds_wait(); *(f32x4*)(us + lane * 4) = un; lds_wait();
        if (sub + 1 < 18) un = S5_LOADU(sub + 1);
        S5_BU();
#pragma unroll 4
        for (int step = 0; step < 16; ++step) { S5_STEP(step); buf[step * 130 + lane] = xr; buf[step * 130 + 65 + lane] = xi; }
        lds_wait();
        f32x4 acr = {0.f, 0.f, 0.f, 0.f}, aci = {0.f, 0.f, 0.f, 0.f};
#pragma unroll
        for (int ks = 0; ks < 16; ++ks) { const float a1 = buf[(lane & 15) * 130 + 4 * ks + (lane >> 4)], a2 = buf[(lane & 15) * 130 + 65 + 4 * ks + (lane >> 4)];
            acr = __builtin_amdgcn_mfma_f32_16x16x4f32(a1, cbr[ks], acr, 0, 0, 0); aci = __builtin_amdgcn_mfma_f32_16x16x4f32(a2, cbi[ks], aci, 0, 0, 0); }
        const f32x4 acc = acr + aci;
#pragma unroll
        for (int r = 0; r < 4; ++r) YS[((size_t)b * TPB + seqpos(s0w + sub * 16 + 4 * (lane >> 4) + r, d)) * 512 + g * 16 + (lane & 15)] = acc[r];
    }
#undef S5_LOADU
#undef S5_STEP
#undef S5_BU
}

DEV void attn_unit(const KP& p, int b, int hq, int qrow0, int nkeys) {
    const int oz = opaque0();
    const att::bf16* ZA = (const att::bf16*)(wsp(p) + OFF_ZA); att::bf16* O = (att::bf16*)(wsp(p) + OFF_O);
    const size_t base = (size_t)b * TPB; const int kvh = hq >> 2;
    __syncthreads();
    att::attn_dense_body<att::bf16>(ZA + (base + qrow0) * LD_ZA + hq * 128, ZA + base * LD_ZA + 1024 + kvh * 128, ZA + base * LD_ZA + 1280 + kvh * 128,
                                    O + (base + qrow0) * 1024 + hq * 128, nkeys, (char*)shm);
    __syncthreads();
}
DEV void phase_mix(const KP& p, int l) {
    const int oz = opaque0();
    unsigned* ctr = (unsigned*)(wsp(p) + OFF_BAR + 14336) + 16 * l;
    volatile int* slot = (volatile int*)(shm + XBST_OFF + 16);
    const int NA = l == 0 ? 736 : 704, NT = NA + 128;
#pragma unroll 1
    for (;;) {
        __syncthreads();
        if (otid() == 0) *slot = (int)__hip_atomic_fetch_add(ctr, 1u, __ATOMIC_RELAXED, __HIP_MEMORY_SCOPE_AGENT);
        __syncthreads();
        const int t = __builtin_amdgcn_readfirstlane(*slot);
        if (t >= NT) break;
        if (t < 128) rwkv_scan(p, t >> 1, t & 1);
        else if (t < 192) mlstm_scan(p, l, t - 128);
        else if (t < 448) s5_scan(p, l, t - 192);
        else if (t >= NA) { __syncthreads(); phase_convert(p, l, 1, t - NA); }
        else { const bool lat = t < 704; const int arg = lat ? t - 448 : t - 704;
            attn_unit(p, lat ? arg >> 6 : arg >> 3, lat ? (arg >> 3) & 7 : arg & 7, lat ? 256 + (arg & 7) * 256 : 0, lat ? 2304 : 256); }
    }
}
DEV void phase_post(const KP& p, int l) {
    const int oz = opaque0();
    const int tid = otid(), wave = __builtin_amdgcn_readfirstlane(tid >> 6), lane = tid & 63;
    const int gw = obid() * 8 + wave, NGW = gridDim.x * 8;
    const float* SC = (const float*)(wsp(p) + OFF_SC); const float* ZF = (const float*)(wsp(p) + OFF_ZF); const float* GR = (const float*)(wsp(p) + OFF_RW) + 9 * SZ_RW;
    bf16_t* AB = (bf16_t*)(wsp(p) + OFF_AB);
    for (int tau = gw; tau < MROWS * 3; tau += NGW) {
        const int row = tau / 3, kind = tau - row * 3;
        if (l == 1 && (row % TPB) < 256) continue;
        const size_t ro = (size_t)row * 512;
        if (kind == 0) {
            float o[8], s1[8];
#pragma unroll
            for (int hh = 0; hh < 8; ++hh) { const int j = hh * 64 + lane; o[hh] = SC[0 * SZ_RW + ro + j] + SC[1 * SZ_RW + ro + j]; s1[hh] = o[hh]; }
#pragma unroll
            for (int hh = 0; hh < 8; ++hh) s1[hh] = wsum(s1[hh]);
            float dl[8], s2[8];
#pragma unroll
            for (int hh = 0; hh < 8; ++hh) { dl[hh] = o[hh] - s1[hh] * (1.f / 64.f); s2[hh] = dl[hh] * dl[hh]; }
#pragma unroll
            for (int hh = 0; hh < 8; ++hh) s2[hh] = wsum(s2[hh]);
#pragma unroll
            for (int hh = 0; hh < 8; ++hh) { const int j = hh * 64 + lane; const float y = dl[hh] * (1.f / sqrtf(s2[hh] * (1.f / 64.f) + 64e-5f));
                AB[0 * SZ_RW + ro + j] = f2bf((y * p.in[oz + 21][l * 512 + j] + p.in[oz + 22][l * 512 + j]) * GR[ro + j]); }
        } else if (kind == 1) {
            float x[8], s1[4];
#pragma unroll
            for (int hh = 0; hh < 4; ++hh) {
#pragma unroll
                for (int e = 0; e < 2; ++e) { const int j = hh * 128 + e * 64 + lane;
                    x[hh * 2 + e] = sigm(ZF[(size_t)row * LD_ZF + ZF_ML + 1536 + j]) * (SC[2 * SZ_RW + ro + j] + SC[3 * SZ_RW + ro + j]); }
                s1[hh] = x[hh * 2] + x[hh * 2 + 1]; }
#pragma unroll
            for (int hh = 0; hh < 4; ++hh) s1[hh] = wsum(s1[hh]);
            float s2[4];
#pragma unroll
            for (int hh = 0; hh < 4; ++hh) { const float mean = s1[hh] * (1.f / 128.f); x[hh * 2] -= mean; x[hh * 2 + 1] -= mean; s2[hh] = x[hh * 2] * x[hh * 2] + x[hh * 2 + 1] * x[hh * 2 + 1]; }
#pragma unroll
            for (int hh = 0; hh < 4; ++hh) s2[hh] = wsum(s2[hh]);
#pragma unroll
            for (int hh = 0; hh < 4; ++hh) { const float rs = 1.f / sqrtf(s2[hh] * (1.f / 128.f) + 1e-6f);
#pragma unroll
                for (int e = 0; e < 2; ++e) { const int j = hh * 128 + e * 64 + lane; AB[1 * SZ_RW + ro + j] = f2bf(x[hh * 2 + e] * rs * p.in[oz + 26][l * 512 + j]); } }
        } else {
#pragma unroll
            for (int hh = 0; hh < 8; ++hh) { const int j = hh * 64 + lane;
                const float y = SC[4 * SZ_RW + ro + j] + SC[5 * SZ_RW + ro + j] + ZF[(size_t)row * LD_ZF + ZF_S5 + j] * p.in[oz + 34][l * 512 + j];
                const float ge = 0.5f * y * (1.f + tanhf(0.7978845608028654f * (y + 0.044715f * y * y * y)));
                AB[2 * SZ_RW + ro + j] = f2bf(ge); }
        }
    }
}

DEV void phase_gatesum(const KP& p, int skip) {
    const int tid = otid(), wave = __builtin_amdgcn_readfirstlane(tid >> 6), lane = tid & 63;
    const int gw = obid() * 8 + wave, NGW = gridDim.x * 8;
    const bf16_t* P = (const bf16_t*)(wsp(p) + OFF_P); const bf16_t* G = (const bf16_t*)(wsp(p) + OFF_G); bf16_t* Y = (bf16_t*)(wsp(p) + OFF_Y);
    for (int tk0 = gw; tk0 < MROWS * 4; tk0 += 2 * NGW) {
        u32x4 pv[2][4], gv[2][4]; bool act[2];
#pragma unroll
        for (int h2 = 0; h2 < 2; ++h2) { const int tk = tk0 + h2 * NGW; const int row = tk >> 2, col = (tk & 3) * 512 + lane * 8;
            act[h2] = tk < MROWS * 4 && !(skip && (row % TPB) < 256);
            if (act[h2]) {
#pragma unroll
                for (int br = 0; br < 4; ++br) { pv[h2][br] = *(const u32x4*)(P + ((size_t)br * MROWS + row) * 2048 + col); gv[h2][br] = *(const u32x4*)(G + (size_t)row * 8192 + br * 2048 + col); } } }
#pragma unroll
        for (int h2 = 0; h2 < 2; ++h2) { if (!act[h2]) continue;
            const int tk = tk0 + h2 * NGW; const int row = tk >> 2, col = (tk & 3) * 512 + lane * 8;
            float sacc[8];
#pragma unroll
            for (int i = 0; i < 8; ++i) sacc[i] = 0.f;
#pragma unroll
            for (int br = 0; br < 4; ++br) {
#pragma unroll
                for (int i = 0; i < 4; ++i) { sacc[2 * i] += __uint_as_float(pv[h2][br][i] << 16) * __uint_as_float(gv[h2][br][i] << 16); sacc[2 * i + 1] += __uint_as_float(pv[h2][br][i] & 0xffff0000u) * __uint_as_float(gv[h2][br][i] & 0xffff0000u); } }
            u32x4 o; o.x = pk2(sacc[0], sacc[1]); o.y = pk2(sacc[2], sacc[3]); o.z = pk2(sacc[4], sacc[5]); o.w = pk2(sacc[6], sacc[7]);
            st16(Y + (size_t)row * 2048 + col, o); }
    }
}
DEV void gsync(const KP& p) {
    XcdBarrier b; b.bar = (unsigned*)(wsp(p) + OFF_BAR); b.x = xb_xcc_id(); b.st = (volatile XB_LAS unsigned*)(XB_LAS unsigned char*)(shm + XBST_OFF);
    xcd_barrier(b);
}
__global__ void __launch_bounds__(512, 2) hybrid_fwd(KP p) {
    cg::grid_group grid = cg::this_grid();
    otid_init();
    if (otid() == 0) { volatile XB_LAS unsigned* st0 = (volatile XB_LAS unsigned*)(XB_LAS unsigned char*)(shm + XBST_OFF); st0[0] = 0u; st0[1] = 0u; }
    __syncthreads();
    (void)xcd_barrier_post((unsigned*)(wsp(p) + OFF_BAR), (volatile XB_LAS unsigned*)(XB_LAS unsigned char*)(shm + XBST_OFF));
    grid.sync();
    phase_convert(p, 0, 0, 0); phase_mod(p); phase_s5disc(p);
    gsync(p);
#pragma unroll 1
    for (int l = 0; l < 2; ++l) {
        const int oz = opaque0();
        const int skip = l;
        const float* MODL = (const float*)(wsp(p) + OFF_MOD) + (size_t)l * 5 * 12288;
        if (l == 1) { __syncthreads(); phase_convert(p, 1, 0, 0); }
        phase_norm(p, l, 0, l == 0, false, l == 1 ? (0 * 8 + 5) : -1);
        gsync(p);
        { EpiWin E{(bf16_t*)(wsp(p) + OFF_ZA), (float*)(wsp(p) + OFF_ZF)}; run_gemm((const bf16_t*)(wsp(p) + OFF_H), (const bf16_t*)(wsp(p) + OFF_W + W_WIN), 6144, 2048, 0, E); }
        gsync(p);
        phase_rwkvprep(p, l); phase_attnprep(p, l);
        gsync(p);
        phase_mix(p, l);
        gsync(p);
        phase_post(p, l);
        gsync(p);
        { EpiGlu2<0> E{(bf16_t*)(wsp(p) + OFF_AB) + 3 * SZ_RW, 512}; run_gemm((const bf16_t*)(wsp(p) + OFF_AB) + 2 * SZ_RW, (const bf16_t*)(wsp(p) + OFF_W + W_GL), 1024, 512, skip, E); }
        { EpiGate E{(bf16_t*)(wsp(p) + OFF_G), p.in[oz + 9] + (size_t)l * 8192}; run_gemm((const bf16_t*)(wsp(p) + OFF_H), (const bf16_t*)(wsp(p) + OFF_W + W_WG), 8192, 2048, skip, E, 144 % (int)gridDim.x); }
        gsync(p);
#pragma unroll 1
        for (int br = 0; br < 4; ++br) {
            EpiPlain E{(bf16_t*)(wsp(p) + OFF_P) + (size_t)br * MROWS * 2048};
            const bf16_t* A = br == 0 ? (const bf16_t*)(wsp(p) + OFF_O) : (const bf16_t*)(wsp(p) + OFF_AB) + (size_t)(br == 1 ? 0 : (br == 2 ? 1 : 3)) * SZ_RW;
            const bf16_t* Bt = (const bf16_t*)(wsp(p) + OFF_W + (br == 0 ? W_BA : (br == 1 ? W_BR : (br == 2 ? W_BM : W_BS))));
            run_gemm(A, Bt, 2048, br == 0 ? 1024 : 512, skip, E, (64 * br) % (int)gridDim.x);
        }
        gsync(p);
        phase_gatesum(p, skip);
        gsync(p);
        { EpiResid E{(float*)(wsp(p) + OFF_X), MODL + 2 * 2048}; run_gemm((const bf16_t*)(wsp(p) + OFF_Y), (const bf16_t*)(wsp(p) + OFF_W + W_WO), 2048, 2048, 1, E); }
        if (l == 0) {
#pragma unroll 1
            for (int q = 0; q < 4; ++q) { EpiPartial E{(bf16_t*)(wsp(p) + OFF_PART) + (size_t)q * 1024 * 2048}; run_gemm_ctxq((const bf16_t*)(wsp(p) + OFF_Y), (const bf16_t*)(wsp(p) + OFF_W + W_WO), 2048, 2048, q, E); } }
        gsync(p);
        phase_norm(p, l, 1, false, skip != 0, l == 0 ? (0 * 8 + 2) : -1);
        gsync(p);
        { EpiGlu2<1> E{(bf16_t*)(wsp(p) + OFF_ACT), FFN}; run_gemm((const bf16_t*)(wsp(p) + OFF_H), (const bf16_t*)(wsp(p) + OFF_W + W_FI), 11264, 2048, skip, E); }
        gsync(p);
        { EpiResid E{(float*)(wsp(p) + OFF_X), MODL + 5 * 2048}; run_gemm((const bf16_t*)(wsp(p) + OFF_ACT), (const bf16_t*)(wsp(p) + OFF_W + W_FO), 2048, FFN, 1, E); }
        if (l == 0) {
#pragma unroll 1
            for (int q = 0; q < 4; ++q) { EpiPartial E{(bf16_t*)(wsp(p) + OFF_PART) + (size_t)q * 1024 * 2048}; run_gemm_ctxq((const bf16_t*)(wsp(p) + OFF_ACT), (const bf16_t*)(wsp(p) + OFF_W + W_FO), 2048, FFN, q, E); } }
        gsync(p);
    }
    phase_final(p);
}

extern "C" void kernel_launch(void* const* d_in, const int* in_sizes, int n_in, void* d_out, int out_size, void* d_ws, size_t ws_size, hipStream_t stream) {
    static int grid = 0;
    if (grid == 0) {
        if (n_in != 44 || out_size != 4 * 2048 * 2048 || ws_size < WS_END) { fprintf(stderr, "kernel_launch: unexpected shapes: n_in %d out %d ws %zu (need %zu)\n", n_in, out_size, ws_size, (size_t)WS_END); grid = -1; return; }
        int dev = 0, cus = 0, per_cu = 0;
        hipGetDevice(&dev);
        hipDeviceGetAttribute(&cus, hipDeviceAttributeMultiprocessorCount, dev);
        if (hipFuncSetAttribute((const void*)hybrid_fwd, hipFuncAttributeMaxDynamicSharedMemorySize, LDS_BYTES) != hipSuccess) { fprintf(stderr, "kernel_launch: hipFuncSetAttribute failed\n"); grid = -1; return; }
        if (hipOccupancyMaxActiveBlocksPerMultiprocessor(&per_cu, (const void*)hybrid_fwd, 512, LDS_BYTES) != hipSuccess || per_cu < 1) { fprintf(stderr, "kernel_launch: occupancy query failed (%d)\n", per_cu); (void)hipGetLastError(); per_cu = 1; }
        grid = cus * per_cu;
        if (grid > 256) grid = 256;
    }
    if (grid < 0) return;
    KP p{};
    for (int i = 0; i < 44; ++i) p.in[i] = (const float*)d_in[i];
    p.out = (float*)d_out; p.ws = (unsigned char*)d_ws;
    (void)hipMemsetAsync((char*)d_ws + OFF_BAR, 0, 16384, stream);
    void* args[] = {&p};
    hipError_t e = hipLaunchCooperativeKernel((const void*)hybrid_fwd, dim3(grid), dim3(512), args, LDS_BYTES, stream);
    if (e != hipSuccess) fprintf(stderr, "cooperative launch failed: %s (grid %d)\n", hipGetErrorString(e), grid);
}
```

```cpp
#include <hip/hip_runtime.h>
#include <hip/hip_cooperative_groups.h>
#include <cstdio>
#include <cstdint>
namespace cg = cooperative_groups;
extern __shared__ __attribute__((aligned(16))) unsigned char shm[];
constexpr int LDS_BYTES = 147456, WTAB_OFF = LDS_BYTES - 512, XBST_OFF = LDS_BYTES - 256;
__device__ __forceinline__ int hwslot() { return (int)(__builtin_amdgcn_s_getreg(4 | (0 << 6) | (5 << 11)) & 63u); }
__device__ __forceinline__ void otid_init() { if ((threadIdx.x & 63) == 0) ((int*)(shm + WTAB_OFF))[hwslot()] = (int)(threadIdx.x >> 6); __syncthreads(); }
__device__ __forceinline__ int otid() {
    const unsigned addr = (unsigned)(size_t)(__attribute__((address_space(3))) unsigned char*)shm + (unsigned)WTAB_OFF + 4u * (unsigned)hwslot();
    int w, lane;
    asm volatile("ds_read_b32 %0, %1\n\ts_waitcnt lgkmcnt(0)" : "=v"(w) : "v"(addr) : "memory");
    asm volatile("v_mbcnt_lo_u32_b32 %0, -1, 0\n\tv_mbcnt_hi_u32_b32 %0, -1, %0" : "=v"(lane));
    return (__builtin_amdgcn_readfirstlane(w) << 6) | lane; }
__device__ __forceinline__ int obid() { int t = (int)blockIdx.x; asm volatile("" : "+s"(t)); return t; }
namespace pg8 {
#define PG8_LAS __attribute__((address_space(3)))
typedef unsigned short bf16_t;
typedef short bf16x8 __attribute__((ext_vector_type(8)));
typedef float f32x4 __attribute__((ext_vector_type(4)));
typedef unsigned u32x4 __attribute__((ext_vector_type(4)));
constexpr int BM = 256, BK = 64, HALF = 128, HTB = HALF * BK * 2  , STAGE_BYTES = 8 * HTB, NXCD = 8, WGM = 8;

__host__ __device__ __forceinline__ int lds_byte(int r, int c) { const int st = (r >> 4) * 2 + (c >> 5), rr = r & 15, cc = c & 31, ob = rr * 64 + cc * 2; return st * 1024 + (ob ^ (((ob >> 9) & 1) << 5)); }
__host__ __device__ __forceinline__ void stage_rc(int b, int& R, int& C) { const int st = b / 1024, sb = b % 1024, swz = sb ^ (((sb >> 9) & 1) << 5); R = (st >> 1) * 16 + swz / 64; C = (st & 1) * 32 + (swz % 64) / 2; }
__host__ __device__ __forceinline__ int perm32(int rho) { const int n = rho >> 4, i = rho & 15; return 8 * (i >> 2) + 4 * n + (i & 3); }

struct Unit { int pm, pn; };
struct Gemm { const bf16_t* A; const bf16_t* Bt; int M, N, K, ld; };

struct Order {
    int nM, nN, nwg, G, c, skip;
    __device__ void init(int nM_, int N, int G_, int c_, int skip_) { nM = nM_; nN = N / BM; nwg = nM * nN; G = G_; c = c_; skip = skip_; }
    __device__ bool next(int i, Unit& u) const {
        const long L = (long)i * G + c; if (L >= nwg) return false;
        int wgid = (int)L; { const int q = nwg / NXCD, r = nwg % NXCD, xcd = wgid % NXCD, off = wgid / NXCD; wgid = (xcd < r ? xcd * (q + 1) : r * (q + 1) + (xcd - r) * q) + off; }
        const int nig = WGM * nN, gid = wgid / nig, fm = gid * WGM, gsz = (nM - fm) < WGM ? (nM - fm) : WGM;
        u.pm = fm + ((wgid % nig) % gsz); u.pn = (wgid % nig) / gsz;
        if (skip == 1) u.pm = (u.pm >> 3) * 9 + 1 + (u.pm & 7); else if (skip == 2) u.pm = u.pm * 9;
        return true;
    }
    __device__ __forceinline__ void a_ready(const Unit&) const {}
    __device__ __forceinline__ void done(const Unit&) const {}
};
__device__ __forceinline__ unsigned cvt_pk_bf16(float lo, float hi) { unsigned r; asm volatile("v_cvt_pk_bf16_f32 %0, %1, %2" : "=v"(r) : "v"(lo), "v"(hi)); return r; }
template <class Epi, class Sched, bool STAMP = false>
__device__ __forceinline__ void gemm_phase(PG8_LAS unsigned char* lds, const Gemm g, const Sched& S, const Epi& E, unsigned long long* stamps) {
    const int tid = otid(), wid = __builtin_amdgcn_readfirstlane(tid >> 6), lane = tid & 63, wr = wid >> 2, wc = wid & 3, fr = lane & 15, fq = lane >> 4;
    const int K = g.K, nt = K / BK;
    int ts_lo = 0, ts_hi = 0, nts = 0; const unsigned long long rt_entry = STAMP ? (unsigned long long)wall_clock64() : 0ull;
#define PG8_STAMP() do { if (STAMP && wid == 0 && nts < 64) { const unsigned long long _c = (unsigned long long)clock64(); \
        ts_lo = (lane == nts) ? (int)(unsigned)_c : ts_lo; ts_hi = (lane == nts) ? (int)(unsigned)(_c >> 32) : ts_hi; ++nts; } } while (0)
    PG8_STAMP();
    unsigned voffA[2], voffB[2];
#pragma unroll
    for (int i = 0; i < 2; ++i) { int R, C; stage_rc(tid * 16 + i * 8192, R, C); const int Rb = Epi::PERM ? ((R & ~31) + perm32(R & 31)) : R;
        voffA[i] = (unsigned)(R * g.ld + C) * 2u; voffB[i] = (unsigned)(Rb * g.ld + C) * 2u; }
    const size_t kstep = (size_t)(BK * 2);
    const size_t hstep = (size_t)HALF * g.ld * 2;
    const size_t tstep = 2 * hstep;
    const unsigned ldsw = (unsigned)wid * 1024u;
    const int aoff = lds_byte(wr * 64 + fr, fq * 8), boff = lds_byte(wc * 32 + fr, fq * 8);
#define PG8_SA(b, h) (((b) * 2 + (h)) * HTB)
#define PG8_SB(b, h) ((4 + (b) * 2 + (h)) * HTB)
#define PG8_STAGE(bufoff, gbase, voff) do { _Pragma("unroll") for (int _i = 0; _i < 2; ++_i) \
        __builtin_amdgcn_global_load_lds((const unsigned*)((const char*)(gbase) + (voff)[_i]), (PG8_LAS unsigned*)(lds + (bufoff) + ldsw + _i * 8192), 16, 0, 0); } while (0)
#define PG8_LDA(dst, b, h) do { _Pragma("unroll") for (int m = 0; m < 4; ++m) _Pragma("unroll") for (int k = 0; k < 2; ++k) dst[m][k] = *(const PG8_LAS bf16x8*)(lds + PG8_SA(b, h) + aoff + m * 2048 + k * 1024); } while (0)
#define PG8_LDB(dst, b, h) do { _Pragma("unroll") for (int n = 0; n < 2; ++n) _Pragma("unroll") for (int k = 0; k < 2; ++k) dst[n][k] = *(const PG8_LAS bf16x8*)(lds + PG8_SB(b, h) + boff + n * 2048 + k * 1024); } while (0)
#define PG8_MMA(ai, bj, At, Bt) do { __builtin_amdgcn_s_setprio(1); _Pragma("unroll") for (int m = 0; m < 4; ++m) _Pragma("unroll") for (int n = 0; n < 2; ++n) _Pragma("unroll") for (int k = 0; k < 2; ++k) \
        acc[ai][bj][m][n] = __builtin_amdgcn_mfma_f32_16x16x32_bf16(Bt[n][k], At[m][k], acc[ai][bj][m][n], 0, 0, 0); __builtin_amdgcn_s_setprio(0); } while (0)
#define PG8_WAIT_V(n) asm volatile("s_waitcnt vmcnt(" #n ")" ::: "memory")
#define PG8_WAIT_L(n) asm volatile("s_waitcnt lgkmcnt(" #n ")" ::: "memory")
#define PG8_BAR __builtin_amdgcn_s_barrier()
#define PG8_SCHED __builtin_amdgcn_sched_barrier(0)
    Unit cur, nxt; int ui = 0;
    if (!S.next(0, cur)) return;
    f32x4 acc[2][2][4][2];
#pragma unroll
    for (int a = 0; a < 2; ++a)
#pragma unroll
        for (int b = 0; b < 2; ++b)
#pragma unroll
            for (int m = 0; m < 4; ++m)
#pragma unroll
                for (int n = 0; n < 2; ++n) acc[a][b][m][n] = (f32x4){0.f, 0.f, 0.f, 0.f};
    bf16x8 At[4][2], B0[2][2], B1[2][2];
    const char* cA = (const char*)g.A + (size_t)cur.pm * tstep; const char* cB = (const char*)g.Bt + (size_t)cur.pn * tstep;
    S.a_ready(cur);
    PG8_STAGE(PG8_SB(0, 0), cB, voffB); PG8_STAGE(PG8_SA(0, 0), cA, voffA); PG8_STAGE(PG8_SB(0, 1), cB + hstep, voffB); PG8_STAGE(PG8_SA(0, 1), cA + hstep, voffA);
    if (wr == 1) PG8_BAR;
    PG8_WAIT_V(4); PG8_BAR;
    PG8_STAGE(PG8_SB(1, 0), cB + kstep, voffB); PG8_STAGE(PG8_SA(1, 0), cA + kstep, voffA); PG8_STAGE(PG8_SB(1, 1), cB + hstep + kstep, voffB);
    PG8_WAIT_V(6); PG8_BAR;
    PG8_STAMP();
    for (;;) {
        const bool has_next = S.next(ui + 1, nxt);
        const char* nA = has_next ? (const char*)g.A + (size_t)nxt.pm * tstep : cA; const char* nB = has_next ? (const char*)g.Bt + (size_t)nxt.pn * tstep : cB;
        for (int t = 0; t < nt; t += 2) {
            const bool last = (t == nt - 2);
            const char* a1 = cA + (size_t)(t + 1) * kstep;
            const char* a2 = last ? nA : cA + (size_t)(t + 2) * kstep; const char* b2 = last ? nB : cB + (size_t)(t + 2) * kstep;
            const char* a3 = a2 + kstep; const char* b3 = b2 + kstep;
            if (last && has_next) S.a_ready(nxt);
            PG8_LDB(B0, 0, 0); PG8_SCHED; PG8_LDA(At, 0, 0); PG8_STAGE(PG8_SA(1, 1), a1 + hstep, voffA);
            PG8_WAIT_L(8); PG8_BAR; PG8_WAIT_L(0); PG8_MMA(0, 0, At, B0); PG8_BAR; PG8_SCHED;
            PG8_LDB(B1, 0, 1); PG8_STAGE(PG8_SB(0, 0), b2, voffB);
            PG8_BAR; PG8_WAIT_L(0); PG8_MMA(0, 1, At, B1); PG8_BAR;
            PG8_LDA(At, 0, 1); PG8_STAGE(PG8_SA(0, 0), a2, voffA);
            PG8_BAR; PG8_WAIT_L(0); PG8_MMA(1, 0, At, B0); PG8_BAR; PG8_SCHED;
            PG8_STAGE(PG8_SB(0, 1), b2 + hstep, voffB);
            PG8_WAIT_V(6); PG8_BAR; PG8_MMA(1, 1, At, B1); PG8_BAR;
            PG8_LDB(B0, 1, 0); PG8_SCHED; PG8_LDA(At, 1, 0); PG8_STAGE(PG8_SA(0, 1), a2 + hstep, voffA);
            PG8_WAIT_L(8); PG8_BAR; PG8_WAIT_L(0); PG8_MMA(0, 0, At, B0); PG8_BAR; PG8_SCHED;
            PG8_LDB(B1, 1, 1); PG8_STAGE(PG8_SB(1, 0), b3, voffB);
            PG8_BAR; PG8_WAIT_L(0); PG8_MMA(0, 1, At, B1); PG8_BAR;
            PG8_LDA(At, 1, 1); PG8_STAGE(PG8_SA(1, 0), a3, voffA);
            PG8_BAR; PG8_WAIT_L(0); PG8_MMA(1, 0, At, B0); PG8_BAR; PG8_SCHED;
            PG8_STAGE(PG8_SB(1, 1), b3 + hstep, voffB);
            PG8_WAIT_V(6); PG8_BAR; PG8_MMA(1, 1, At, B1); PG8_BAR;
        }
        PG8_STAMP();
        if constexpr (!Epi::AFTER_DRAIN) { E(acc, cur, wr, wc, fr, fq); S.done(cur); }
        PG8_STAMP();
        if (!has_next) break;
#pragma unroll
        for (int a = 0; a < 2; ++a)
#pragma unroll
            for (int b = 0; b < 2; ++b)
#pragma unroll
                for (int m = 0; m < 4; ++m)
#pragma unroll
                    for (int n = 0; n < 2; ++n) acc[a][b][m][n] = (f32x4){0.f, 0.f, 0.f, 0.f};
        cur = nxt; cA = nA; cB = nB; ++ui;
    }
    PG8_WAIT_V(0);
    if (wr == 0) PG8_BAR;
    PG8_BAR;
    if constexpr (Epi::AFTER_DRAIN) { E.fused(acc, cur, wr, wc, fr, fq, lds, wid, lane); S.done(cur); }
    PG8_STAMP();
    if (STAMP && wid == 0) { stamps[lane] = lane < nts ? (((unsigned long long)(unsigned)ts_hi << 32) | (unsigned)ts_lo) : 0ull;
        if (lane == 62) stamps[62] = rt_entry; if (lane == 63) stamps[63] = (unsigned long long)wall_clock64(); }
#undef PG8_STAMP
#undef PG8_SA
#undef PG8_SB
#undef PG8_STAGE
#undef PG8_LDA
#undef PG8_LDB
#undef PG8_MMA
#undef PG8_WAIT_V
#undef PG8_WAIT_L
#undef PG8_BAR
#undef PG8_SCHED
}
}

namespace att {
using bf16 = unsigned short;
constexpr int   D = 128, NW = 8, QBLK = 32, KVBLK = 64;
constexpr float SCALE = 0.088388347648318440f;
constexpr float THR = 8.f;
constexpr int SDEPTH = 2;
constexpr int LDQ = 1536, LDK = 1536, LDO = 1024;
constexpr size_t SHM_V = KVBLK * D * 2, SHM_K = KVBLK * D * 2, SHM_ATTN = 2 * SHM_V + 2 * SHM_K + NW * 64 * 4;
__device__ __forceinline__ unsigned short f2bf_att(float f) { unsigned u = __float_as_uint(f); u += 0x7FFFu + ((u >> 16) & 1u); return (unsigned short)(u >> 16); }
using bf16x8 = __attribute__((ext_vector_type(8))) short;
using s16x4  = __attribute__((ext_vector_type(4))) short;
using f32x16 = __attribute__((ext_vector_type(16))) float;
using f32x8  = __attribute__((ext_vector_type(8))) float;
using u32x4  = __attribute__((ext_vector_type(4))) unsigned;
#define KSWZ(row, colB) ((row) * 256 + ((colB) ^ (((row) & 7) << 4)))
#define SBAR() __builtin_amdgcn_sched_barrier(0)
__device__ __forceinline__ int crow(int r, int hi) { return (r & 3) + 8 * (r >> 2) + 4 * hi; }
__device__ __forceinline__ unsigned cvtpk(float lo, float hi) {
  unsigned r; asm volatile("v_cvt_pk_bf16_f32 %0, %1, %2" : "=v"(r) : "v"(lo), "v"(hi)); return r;
}
template <typename TIn> struct Stage;
template <> struct Stage<bf16>  { using T = bf16x8;
  __device__ static __forceinline__ T ld8(const bf16* p) { return *reinterpret_cast<const bf16x8*>(p); }
  __device__ static __forceinline__ bf16x8 tobf(T x) { return x; } };
template <> struct Stage<float> { using T = f32x8;
  __device__ static __forceinline__ T ld8(const float* p) { return *reinterpret_cast<const f32x8*>(p); }
  __device__ static __forceinline__ bf16x8 tobf(T x) {
    u32x4 w = {cvtpk(x[0], x[1]), cvtpk(x[2], x[3]), cvtpk(x[4], x[5]), cvtpk(x[6], x[7])}; return *reinterpret_cast<bf16x8*>(&w); } };

__device__ __forceinline__ void partialSM(f32x16& p0, f32x16& p1, float& m_reg, float& mn, float& alpha) {
  constexpr float C = SCALE * 1.4426950408889634f;
  float pmax = p0[0]; for (int r = 1; r < 16; ++r) pmax = fmaxf(pmax, p0[r]); for (int r = 0; r < 16; ++r) pmax = fmaxf(pmax, p1[r]);
  { auto rr = __builtin_amdgcn_permlane32_swap(__float_as_uint(pmax), __float_as_uint(pmax), false, false);
    pmax = fmaxf(__uint_as_float(rr[0]), __uint_as_float(rr[1])); }
  if (__builtin_expect(__all(pmax - m_reg <= THR / SCALE), 1)) { mn = m_reg; alpha = 1.f; }
  else { mn = fmaxf(m_reg, pmax); alpha = __builtin_amdgcn_exp2f((m_reg - mn) * C); m_reg = mn; }
  float mnC = -mn * C;
  for (int r = 0; r < 16; ++r) p0[r] = fmaf(p0[r], C, mnC); for (int r = 0; r < 16; ++r) p1[r] = fmaf(p1[r], C, mnC);
  for (int r = 0; r < 16; ++r) p0[r] = __builtin_amdgcn_exp2f(p0[r]);
}
__device__ __forceinline__ void finishSM(f32x16& p0, f32x16& p1, float alpha, float& l_reg, bf16x8& pa0, bf16x8& pa1, bf16x8& pa2, bf16x8& pa3) {
  for (int r = 0; r < 16; ++r) p1[r] = __builtin_amdgcn_exp2f(p1[r]);
  float ps = 0; for (int r = 0; r < 16; ++r) ps += p0[r]; for (int r = 0; r < 16; ++r) ps += p1[r];
  { auto rr = __builtin_amdgcn_permlane32_swap(__float_as_uint(ps), __float_as_uint(ps), false, false);
    ps = __uint_as_float(rr[0]) + __uint_as_float(rr[1]); }
  l_reg = l_reg * alpha + ps;
#define PK4(P, BASE, OUT) do { unsigned a0 = cvtpk(P[BASE + 0], P[BASE + 1]), a1 = cvtpk(P[BASE + 2], P[BASE + 3]);   \
    unsigned b0 = cvtpk(P[BASE + 4], P[BASE + 5]), b1 = cvtpk(P[BASE + 6], P[BASE + 7]);                              \
    auto r0 = __builtin_amdgcn_permlane32_swap(a0, b0, false, false); auto r1 = __builtin_amdgcn_permlane32_swap(a1, b1, false, false); \
    u32x4 w = {r0[0], r1[0], r0[1], r1[1]}; OUT = *reinterpret_cast<bf16x8*>(&w); } while (0)
  PK4(p0, 0, pa0); PK4(p0, 8, pa1); PK4(p1, 0, pa2); PK4(p1, 8, pa3);
#undef PK4
}
__device__ __forceinline__ void qkt(f32x16& p0, f32x16& p1, const bf16* Ks, const bf16x8* qr, int r32, int hi) {
  p0 = f32x16{}; p1 = f32x16{};
  for (int d0 = 0; d0 < 8; ++d0) { int cb = (d0 * 16 + hi * 8) * 2;
    bf16x8 b0 = *reinterpret_cast<const bf16x8*>((const char*)Ks + KSWZ(r32, cb));
    bf16x8 b1 = *reinterpret_cast<const bf16x8*>((const char*)Ks + KSWZ(32 + r32, cb));
    p0 = __builtin_amdgcn_mfma_f32_32x32x16_bf16(b0, qr[d0], p0, 0, 0, 0);
    p1 = __builtin_amdgcn_mfma_f32_32x32x16_bf16(b1, qr[d0], p1, 0, 0, 0); }
}
__device__ __forceinline__ int v_st(int k, int c) { const int kk = (k & ~0xC) | ((k & 4) << 1) | ((k & 8) >> 1); return ((kk >> 3) * 4 + (c >> 5)) * 512 + ((kk & 7) * 32 + (c & 31)) * 2; }
__device__ __forceinline__ int v_rd_base(int lane) { return ((lane & 3) << 3) | (((lane >> 2) & 3) << 6) | (((lane >> 4) & 1) << 5) | (((lane >> 5) & 1) << 8); }
constexpr int v_rd_off(int d0, int ks, int half) { return d0 * 512 + ks * 4096 + half * 2048; }
template <int OFF> __device__ __forceinline__ s16x4 tr_read(int vb) {
  s16x4 r; asm volatile("ds_read_b64_tr_b16 %0, %1 offset:%2" : "=&v"(r) : "v"(vb), "i"(OFF) : "memory"); return r;
}
template <int D0> __device__ __forceinline__ void pv_one(f32x16& od, int vb, bf16x8 pa0, bf16x8 pa1, bf16x8 pa2, bf16x8 pa3) {
  const s16x4 l0 = tr_read<v_rd_off(D0, 0, 0)>(vb), h0 = tr_read<v_rd_off(D0, 0, 1)>(vb), l1 = tr_read<v_rd_off(D0, 1, 0)>(vb), h1 = tr_read<v_rd_off(D0, 1, 1)>(vb);
  const s16x4 l2 = tr_read<v_rd_off(D0, 2, 0)>(vb), h2 = tr_read<v_rd_off(D0, 2, 1)>(vb), l3 = tr_read<v_rd_off(D0, 3, 0)>(vb), h3 = tr_read<v_rd_off(D0, 3, 1)>(vb);
  asm volatile("s_waitcnt lgkmcnt(0)" ::: "memory"); SBAR();
#define PK(L, H) (bf16x8){L[0], L[1], L[2], L[3], H[0], H[1], H[2], H[3]}
  od = __builtin_amdgcn_mfma_f32_32x32x16_bf16(pa0, PK(l0, h0), od, 0, 0, 0);
  od = __builtin_amdgcn_mfma_f32_32x32x16_bf16(pa1, PK(l1, h1), od, 0, 0, 0);
  od = __builtin_amdgcn_mfma_f32_32x32x16_bf16(pa2, PK(l2, h2), od, 0, 0, 0);
  od = __builtin_amdgcn_mfma_f32_32x32x16_bf16(pa3, PK(l3, h3), od, 0, 0, 0);
#undef PK
}
__device__ __forceinline__ void pv_d0(f32x16* o, int vb, bf16x8 pa0, bf16x8 pa1, bf16x8 pa2, bf16x8 pa3) {
  pv_one<0>(o[0], vb, pa0, pa1, pa2, pa3); pv_one<1>(o[1], vb, pa0, pa1, pa2, pa3); pv_one<2>(o[2], vb, pa0, pa1, pa2, pa3); pv_one<3>(o[3], vb, pa0, pa1, pa2, pa3);
}

template <typename TQ>
__device__ __forceinline__ void attn_dense_body(const TQ* __restrict__ Qb, const bf16* __restrict__ Kh, const bf16* __restrict__ Vh,
                                                bf16* __restrict__ Ob, int seq, char* lds) {
  using St = Stage<bf16>; using SQ = Stage<TQ>;
  const int tid = otid(), wid = tid >> 6, lane = tid & 63, r32 = lane & 31, hi = lane >> 5;
  bf16* V_lds = (bf16*)lds; bf16* K_lds = (bf16*)(lds + 2 * SHM_V);
  float* ws = (float*)(lds + 2 * SHM_V + 2 * SHM_K) + wid * 64; float* li_l = ws; float* al_l = ws + 32;
  float m_reg = -1e30f, l_reg = 0; f32x16 o[4] = {}; bf16x8 qr[8];
  const TQ* Qw = Qb + (int)(wid * QBLK + r32) * LDQ + hi * 8;
#pragma unroll
  for (int d0 = 0; d0 < 8; ++d0) qr[d0] = SQ::tobf(SQ::ld8(Qw + d0 * 16));
  const int sr = tid >> 4, sc = (tid & 15) * 8, vst0 = v_st(sr, sc), vst1 = v_st(32 + sr, sc);
  const int vb0 = (int)(uintptr_t)V_lds + v_rd_base(lane);
  struct { typename St::T vs0, vs1, ks0, ks1; } sr_[SDEPTH];
#define SLOAD(i, k0) do { sr_[i].vs0 = St::ld8(&Vh[(int)((k0) + sr) * LDK + sc]); sr_[i].vs1 = St::ld8(&Vh[(int)((k0) + 32 + sr) * LDK + sc]); \
    sr_[i].ks0 = St::ld8(&Kh[(int)((k0) + sr) * LDK + sc]); sr_[i].ks1 = St::ld8(&Kh[(int)((k0) + 32 + sr) * LDK + sc]); } while (0)
#define SWRITE(b, i) do { *(bf16x8*)((char*)V_lds + (b) * SHM_V + vst0) = St::tobf(sr_[i].vs0);          \
    *(bf16x8*)((char*)V_lds + (b) * SHM_V + vst1) = St::tobf(sr_[i].vs1); int kc = sc * 2;               \
    *(bf16x8*)((char*)K_lds + (b) * SHM_K + KSWZ(sr, kc)) = St::tobf(sr_[i].ks0);                       \
    *(bf16x8*)((char*)K_lds + (b) * SHM_K + KSWZ(32 + sr, kc)) = St::tobf(sr_[i].ks1); } while (0)
#define SWAIT() do { if constexpr (SDEPTH == 2) asm volatile("s_waitcnt vmcnt(4)" ::: "memory"); else asm volatile("s_waitcnt vmcnt(0)" ::: "memory"); } while (0)
#define RESC(a) do { if (__any((a) < 1.f)) { if (hi == 0) al_l[r32] = (a); asm volatile("s_waitcnt lgkmcnt(0)" ::: "memory"); \
    for (int d = 0; d < 4; ++d) for (int r = 0; r < 16; ++r) o[d][r] *= al_l[crow(r, hi)]; } } while (0)
  f32x16 pA0, pA1, pB0, pB1; float mnA, mnB, alA, alB; bf16x8 pa0, pa1, pa2, pa3; const int NT = seq / KVBLK;
  constexpr int SE = 0, SO = SDEPTH - 1;
  SLOAD(SE, 0); asm volatile("s_waitcnt vmcnt(0)" ::: "memory"); SWRITE(0, SE); __syncthreads();
  qkt(pA0, pA1, K_lds, qr, r32, hi); partialSM(pA0, pA1, m_reg, mnA, alA);
  SLOAD(SO, KVBLK); if constexpr (SDEPTH == 2) { if (2 < NT) SLOAD(SE, 2 * KVBLK); }
  SWAIT(); SWRITE(1, SO); __syncthreads();
  for (int j = 1; j + 1 < NT; j += 2) {
    SBAR(); qkt(pB0, pB1, (bf16*)((char*)K_lds + SHM_K), qr, r32, hi);
    finishSM(pA0, pA1, alA, l_reg, pa0, pa1, pa2, pa3); SBAR();
    SLOAD(SO, (j + SDEPTH) * KVBLK); SBAR();
    pv_d0(o, vb0, pa0, pa1, pa2, pa3); partialSM(pB0, pB1, m_reg, mnB, alB);
    __syncthreads(); SWAIT(); SWRITE(0, SE);
    RESC(alB); __syncthreads();
    SBAR(); qkt(pA0, pA1, K_lds, qr, r32, hi);
    finishSM(pB0, pB1, alB, l_reg, pa0, pa1, pa2, pa3); SBAR();
    if (SDEPTH == 1 || j + 3 < NT) SLOAD(SE, (j + 1 + SDEPTH) * KVBLK); SBAR();
    pv_d0(o, vb0 + (int)SHM_V, pa0, pa1, pa2, pa3); partialSM(pA0, pA1, m_reg, mnA, alA);
    __syncthreads(); SWAIT(); SWRITE(1, SO);
    RESC(alA); __syncthreads();
  }
  SBAR(); qkt(pB0, pB1, (bf16*)((char*)K_lds + SHM_K), qr, r32, hi);
  finishSM(pA0, pA1, alA, l_reg, pa0, pa1, pa2, pa3); SBAR();
  pv_d0(o, vb0, pa0, pa1, pa2, pa3); partialSM(pB0, pB1, m_reg, mnB, alB);
  __syncthreads(); RESC(alB);
  finishSM(pB0, pB1, alB, l_reg, pa0, pa1, pa2, pa3); SBAR();
  pv_d0(o, vb0 + (int)SHM_V, pa0, pa1, pa2, pa3);
  if (hi == 0) li_l[r32] = l_reg; asm volatile("s_waitcnt lgkmcnt(0)" ::: "memory");
  float rli[16];
#pragma unroll
  for (int r = 0; r < 16; ++r) rli[r] = __builtin_amdgcn_rcpf(li_l[crow(r, hi)]);
  bf16* Ow = Ob + (int)(wid * QBLK) * LDO;
#pragma unroll
  for (int r = 0; r < 16; ++r) { int orow = crow(r, hi);
    for (int d0 = 0; d0 < 4; ++d0) Ow[(int)orow * LDO + d0 * 32 + r32] = f2bf_att(o[d0][r] * rli[r]); }
#undef SLOAD
#undef SWRITE
#undef SWAIT
#undef RESC
}

}

#define XB_TMO      128
#define XB_XCNT(j)  (256  + 64 * (j))
#define XB_XSUB(j)  (1280 + 64 * (j))
#define XB_XGEN(j)  (2304 + 64 * (j))
#define XB_TOP      3328
#define XB_TOPGEN   3392
#define XCD_BAR_WORDS 3456
#define XB_SPIN_CAP (1u << 20)
#define XB_LAS __attribute__((address_space(3)))

__device__ __forceinline__ unsigned xb_ld(unsigned* p)              { return __hip_atomic_load(p, __ATOMIC_RELAXED, __HIP_MEMORY_SCOPE_AGENT); }
__device__ __forceinline__ unsigned xb_add(unsigned* p, unsigned v) { return __hip_atomic_fetch_add(p, v, __ATOMIC_RELAXED, __HIP_MEMORY_SCOPE_AGENT); }
__device__ __forceinline__ unsigned xb_xcc_id() { return (unsigned)__builtin_amdgcn_s_getreg((3 << 11) | 20) & 0xFu; }
#define XB_SPIN(cond, bar) do { unsigned _sp = 0; while (cond) { __builtin_amdgcn_s_sleep(1); \
    if ((++_sp & 255u) == 0u) { if (xb_ld(&(bar)[XB_TMO])) break; if (_sp > XB_SPIN_CAP) { atomicAdd(&(bar)[XB_TMO], 1u); break; } } } } while (0)

struct XcdBarrier {
    unsigned* bar; unsigned x;
    volatile XB_LAS unsigned* st;
};

__device__ __forceinline__ XcdBarrier xcd_barrier_post(unsigned* bar, volatile XB_LAS unsigned* st) {
    XcdBarrier b; b.bar = bar; b.x = xb_xcc_id(); b.st = st;
    if (otid() == 0) (void)xb_add(&bar[XB_XCNT(b.x)], 1u);
    return b;
}
__device__ __forceinline__ void xcd_barrier_complete(unsigned* bar, unsigned x, unsigned& nloc, unsigned& nx) {
    const unsigned G = gridDim.x * gridDim.y * gridDim.z;
    unsigned sum, cnt, mine, sp = 0u;
    for (;;) {
        sum = 0u; cnt = 0u; mine = 0u;
#pragma unroll
        for (unsigned j = 0; j < 16; ++j) { const unsigned c = xb_ld(&bar[XB_XCNT(j)]); sum += c; cnt += (c > 0u) ? 1u : 0u; mine = (j == x) ? c : mine; }
        if (sum == G) break;
        __builtin_amdgcn_s_sleep(1);
        if ((++sp & 255u) == 0u) { if (xb_ld(&bar[XB_TMO])) break; if (sp > XB_SPIN_CAP) { atomicAdd(&bar[XB_TMO], 1u); break; } }
    }
    nloc = mine > 0u ? mine : 1u; nx = cnt > 0u ? cnt : 1u;
}

__device__ __forceinline__ void xcd_barrier(const XcdBarrier& b) {
    asm volatile("s_waitcnt vmcnt(0)" ::: "memory");
    __syncthreads();
    if (otid() == 0) {
        unsigned* bar = b.bar;
        __builtin_amdgcn_s_waitcnt(0);
        unsigned nloc = b.st[0], nx = b.st[1];
        if (nloc == 0u) { xcd_barrier_complete(bar, b.x, nloc, nx); b.st[0] = nloc; b.st[1] = nx; }
        const unsigned old = xb_add(&bar[XB_XSUB(b.x)], 1u);
        const unsigned gen = old / nloc;
        if (old + 1u == (gen + 1u) * nloc) {
            __builtin_amdgcn_fence(__ATOMIC_RELEASE, "agent");
            asm volatile("s_waitcnt vmcnt(0)" ::: "memory");
            const unsigned og = xb_add(&bar[XB_TOP], 1u);
            const unsigned tg = og / nx;
            if (og + 1u == (tg + 1u) * nx) xb_add(&bar[XB_TOPGEN], 1u);
            else XB_SPIN(xb_ld(&bar[XB_TOPGEN]) == tg, bar);
            __builtin_amdgcn_fence(__ATOMIC_ACQUIRE, "agent");
            xb_add(&bar[XB_XGEN(b.x)], 1u);
            asm volatile("s_waitcnt vmcnt(0)" ::: "memory");
        } else {
            XB_SPIN(xb_ld(&bar[XB_XGEN(b.x)]) == gen, bar);
            __builtin_amdgcn_fence(__ATOMIC_ACQUIRE, "agent");
            asm volatile("s_waitcnt vmcnt(0)" ::: "memory");
        }
    }
    __syncthreads();
}


#define DEV __device__ __forceinline__
typedef unsigned short bf16_t;
typedef float f32x4 __attribute__((ext_vector_type(4)));
typedef float f32x2 __attribute__((ext_vector_type(2)));
typedef float f32x16 __attribute__((ext_vector_type(16)));
typedef short bf16x8 __attribute__((ext_vector_type(8)));
typedef unsigned u32x2 __attribute__((ext_vector_type(2)));
typedef unsigned u32x4 __attribute__((ext_vector_type(4)));

constexpr int MROWS = 9216, TPB = 2304;
constexpr int LD_ZA = 1536, LD_ZF = 4608;
constexpr int ZF_ML = 1792, ZF_MLG = 3840, ZF_S5 = 4096;
constexpr int FFN = 5632;
constexpr size_t SZ_RW = (size_t)MROWS * 512;
constexpr size_t W_WIN = 0, W_WG = W_WIN + 6144ull * 2048 * 2, W_BA = W_WG + 8192ull * 2048 * 2, W_BR = W_BA + 2048ull * 1024 * 2, W_BM = W_BR + 2048ull * 512 * 2,
                 W_BS = W_BM + 2048ull * 512 * 2, W_WO = W_BS + 2048ull * 512 * 2, W_FI = W_WO + 2048ull * 2048 * 2, W_FO = W_FI + 11264ull * 2048 * 2,
                 W_GL = W_FO + 2048ull * 5632 * 2, W_LW = W_GL + 1024ull * 512 * 2  ,
                 W_END = W_LW + 4 * 512ull * 64 * 2 + 512ull * 128 * 2;
constexpr size_t OFF_W = 0;
constexpr size_t OFF_X = OFF_W + W_END;
constexpr size_t OFF_H = OFF_X + (size_t)MROWS * 2048 * 4;
constexpr size_t OFF_ZA = OFF_H + (size_t)MROWS * 2048 * 2;
constexpr size_t OFF_ZF = OFF_ZA + (size_t)MROWS * 1536 * 2;
constexpr size_t OFF_O = OFF_ZF + (size_t)MROWS * 4608 * 4;
constexpr size_t OFF_RW = OFF_O + (size_t)MROWS * 1024 * 2;
constexpr size_t OFF_C12 = OFF_RW + 10 * SZ_RW * 4;
constexpr size_t OFF_SC = OFF_C12 + 2ull * MROWS * 16 * 4;
constexpr size_t OFF_AB = OFF_SC + 6 * SZ_RW * 4;
constexpr size_t OFF_MOD = OFF_AB + 4 * SZ_RW * 2;
constexpr size_t OFF_ABAR = OFF_MOD + 2ull * 5 * 12288 * 4;
constexpr size_t OFF_BBAR = OFF_ABAR + 8192ull * 2 * 4;
constexpr size_t OFF_BAR = OFF_BBAR + 8192ull * 32 * 4;
constexpr size_t WS_END = OFF_BAR + 16384;
constexpr size_t OFF_G = OFF_RW;
constexpr size_t OFF_P = OFF_ZF;
constexpr size_t OFF_Y = OFF_H;
constexpr size_t OFF_ACT = OFF_ZF;
constexpr size_t OFF_PART = OFF_ZF + 112ull * 1048576;
static_assert((size_t)MROWS * 8192 * 2 <= 10 * SZ_RW * 4, "G overlay");
static_assert((size_t)MROWS * 2048 * 8 <= (size_t)MROWS * 4608 * 4 && (size_t)MROWS * 5632 * 2 <= (size_t)MROWS * 4608 * 4, "ZF overlays");
static_assert(OFF_ACT + (size_t)MROWS * 5632 * 2 <= OFF_PART && OFF_PART + 4ull * 1024 * 2048 * 2 <= OFF_ZF + (size_t)MROWS * 4608 * 4, "partials overlay");

struct KP { const float* in[44]; float* out; unsigned char* ws; };


DEV int opaque0() { int z; asm volatile("s_mov_b32 %0, 0" : "=s"(z)); return z; }
DEV unsigned char* wsp(const KP& p) { return p.ws + (size_t)(unsigned)opaque0(); }
template <int CTRL> DEV float dppf(float v) { return __builtin_bit_cast(float, __builtin_amdgcn_update_dpp(0, __builtin_bit_cast(int, v), CTRL, 0xF, 0xF, true)); }
DEV float wsum(float v) {
    v += dppf<0xB1>(v); v += dppf<0x4E>(v); v += dppf<0x141>(v); v += dppf<0x140>(v);
    const float a = __builtin_bit_cast(float, __builtin_amdgcn_readlane(__builtin_bit_cast(int, v), 0)), b = __builtin_bit_cast(float, __builtin_amdgcn_readlane(__builtin_bit_cast(int, v), 16));
    const float c = __builtin_bit_cast(float, __builtin_amdgcn_readlane(__builtin_bit_cast(int, v), 32)), d = __builtin_bit_cast(float, __builtin_amdgcn_readlane(__builtin_bit_cast(int, v), 48));
    return (a + b) + (c + d);
}
DEV float sigm(float x) { return 1.f / (1.f + __expf(-x)); }
DEV float siluf(float x) { return x / (1.f + __expf(-x)); }
typedef __bf16 bf16x2_t __attribute__((ext_vector_type(2)));
DEV unsigned pk2(float lo, float hi) { f32x2 f = {lo, hi}; bf16x2_t r = __builtin_convertvector(f, bf16x2_t); return __builtin_bit_cast(unsigned, r); }
DEV bf16_t f2bf(float f) { unsigned u = __float_as_uint(f); u += 0x7FFFu + ((u >> 16) & 1u); return (bf16_t)(u >> 16); }
DEV float bf2f(bf16_t b) { return __uint_as_float(((unsigned)b) << 16); }
DEV void lds_wait() { asm volatile("s_waitcnt lgkmcnt(0)" ::: "memory"); }
DEV int seqpos(int s, int d) { return d == 0 ? s : (s < 256 ? 255 - s : 2559 - s); }
DEV int crow16(int r, int hi) { return (r & 3) + 8 * (r >> 2) + 4 * hi; }

DEV void st16(void* ptr, u32x4 v) { *(u32x4*)ptr = v; }
DEV void st16f(void* ptr, f32x4 v) { *(f32x4*)ptr = v; }
DEV u32x4 pack8(const f32x4 a, const f32x4 b) { u32x4 o; o.x = pk2(a[0], a[1]); o.y = pk2(a[2], a[3]); o.z = pk2(b[0], b[1]); o.w = pk2(b[2], b[3]); return o; }
struct EpiWin {
    static constexpr bool PERM = true, AFTER_DRAIN = false;
    bf16_t* ZA; float* ZF;
    DEV void operator()(const pg8::f32x4 (&acc)[2][2][4][2], const pg8::Unit& u, int wr, int wc, int fr, int fq) const {
        const int row0 = u.pm * 256 + wr * 64 + fr, cb0 = u.pn * 256 + wc * 32 + 8 * fq;
#pragma unroll
        for (int ai = 0; ai < 2; ++ai)
#pragma unroll
            for (int m = 0; m < 4; ++m) { const size_t row = row0 + ai * 128 + m * 16;
#pragma unroll
                for (int bj = 0; bj < 2; ++bj) { const int cb = cb0 + bj * 128; const f32x4 v0 = acc[ai][bj][m][0], v1 = acc[ai][bj][m][1];
                    if (u.pn < 6) st16(ZA + row * LD_ZA + cb, pack8(v0, v1));
                    else { float* zp = ZF + row * LD_ZF + (cb - 1536); st16f(zp, v0); st16f(zp + 4, v1); } } }
    }
};
struct EpiGate {
    static constexpr bool PERM = true, AFTER_DRAIN = false;
    bf16_t* G; const float* bg;
    DEV void operator()(const pg8::f32x4 (&acc)[2][2][4][2], const pg8::Unit& u, int wr, int wc, int fr, int fq) const {
        const int row0 = u.pm * 256 + wr * 64 + fr, cb0 = u.pn * 256 + wc * 32 + 8 * fq;
        f32x4 bv[2][2];
#pragma unroll
        for (int bj = 0; bj < 2; ++bj)
#pragma unroll
            for (int n = 0; n < 2; ++n) bv[bj][n] = *(const f32x4*)(bg + cb0 + bj * 128 + 4 * n);
#pragma unroll
        for (int ai = 0; ai < 2; ++ai)
#pragma unroll
            for (int m = 0; m < 4; ++m) { const size_t row = row0 + ai * 128 + m * 16;
#pragma unroll
                for (int bj = 0; bj < 2; ++bj) { f32x4 s0, s1;
#pragma unroll
                    for (int i = 0; i < 4; ++i) { s0[i] = sigm(acc[ai][bj][m][0][i] + bv[bj][0][i]); s1[i] = sigm(acc[ai][bj][m][1][i] + bv[bj][1][i]); }
                    st16(G + row * 8192 + cb0 + bj * 128, pack8(s0, s1)); } }
    }
};
template <int ACT> struct EpiGlu2 {
    static constexpr bool PERM = true, AFTER_DRAIN = false;
    bf16_t* O; int ldo;
    DEV void operator()(const pg8::f32x4 (&acc)[2][2][4][2], const pg8::Unit& u, int wr, int wc, int fr, int fq) const {
        const int row0 = u.pm * 256 + wr * 64 + fr, col0 = u.pn * 128 + wc * 32 + 8 * fq;
#pragma unroll
        for (int ai = 0; ai < 2; ++ai)
#pragma unroll
            for (int m = 0; m < 4; ++m) { const size_t row = row0 + ai * 128 + m * 16; f32x4 r[2];
#pragma unroll
                for (int n = 0; n < 2; ++n) { const pg8::f32x4 a = acc[ai][0][m][n], b = acc[ai][1][m][n];
#pragma unroll
                    for (int i = 0; i < 4; ++i) r[n][i] = ACT == 0 ? a[i] * sigm(b[i]) : siluf(a[i]) * b[i]; }
                st16(O + row * ldo + col0, pack8(r[0], r[1])); }
    }
};
struct EpiPlain {
    static constexpr bool PERM = true, AFTER_DRAIN = false;
    bf16_t* P;
    DEV void operator()(const pg8::f32x4 (&acc)[2][2][4][2], const pg8::Unit& u, int wr, int wc, int fr, int fq) const {
        const int row0 = u.pm * 256 + wr * 64 + fr, cb0 = u.pn * 256 + wc * 32 + 8 * fq;
#pragma unroll
        for (int ai = 0; ai < 2; ++ai)
#pragma unroll
            for (int m = 0; m < 4; ++m) { const size_t row = row0 + ai * 128 + m * 16;
#pragma unroll
                for (int bj = 0; bj < 2; ++bj) st16(P + row * 2048 + cb0 + bj * 128, pack8(acc[ai][bj][m][0], acc[ai][bj][m][1])); }
    }
};
struct EpiResid {
    static constexpr bool PERM = true, AFTER_DRAIN = false;
    float* X; const float* mod;
    DEV void operator()(const pg8::f32x4 (&acc)[2][2][4][2], const pg8::Unit& u, int wr, int wc, int fr, int fq) const {
        const int row0 = u.pm * 256 + wr * 64 + fr, cb0 = u.pn * 256 + wc * 32 + 8 * fq;
        const int b = u.pm / 9, mr = (u.pm - b * 9) == 0 ? 4 : b;
        const float* mp = mod + (size_t)mr * 12288;
        f32x4 gv[2][2];
#pragma unroll
        for (int bj = 0; bj < 2; ++bj)
#pragma unroll
            for (int n = 0; n < 2; ++n) gv[bj][n] = *(const f32x4*)(mp + cb0 + bj * 128 + 4 * n);
#pragma unroll
        for (int ai = 0; ai < 2; ++ai)
#pragma unroll
            for (int m = 0; m < 4; ++m) { const size_t row = row0 + ai * 128 + m * 16;
#pragma unroll
                for (int bj = 0; bj < 2; ++bj) { float* xp = X + row * 2048 + cb0 + bj * 128;
                    f32x4 x0 = *(const f32x4*)xp, x1 = *(const f32x4*)(xp + 4);
                    x0 += gv[bj][0] * acc[ai][bj][m][0]; x1 += gv[bj][1] * acc[ai][bj][m][1];
                    st16f(xp, x0); st16f(xp + 4, x1); } }
    }
};
struct EpiPartial {
    static constexpr bool PERM = true, AFTER_DRAIN = false;
    bf16_t* PP;
    DEV void operator()(const pg8::f32x4 (&acc)[2][2][4][2], const pg8::Unit& u, int wr, int wc, int fr, int fq) const {
        const int row0 = (u.pm / 9) * 256 + wr * 64 + fr, cb0 = u.pn * 256 + wc * 32 + 8 * fq;
#pragma unroll
        for (int ai = 0; ai < 2; ++ai)
#pragma unroll
            for (int m = 0; m < 4; ++m) { const size_t row = row0 + ai * 128 + m * 16;
#pragma unroll
                for (int bj = 0; bj < 2; ++bj) st16(PP + row * 2048 + cb0 + bj * 128, pack8(acc[ai][bj][m][0], acc[ai][bj][m][1])); }
    }
};
template <class Epi> DEV void run_gemm(const bf16_t* A, const bf16_t* Bt, int N, int K, int skip, const Epi& E, int rot = 0) {
    const int G_ = (int)gridDim.x; int c_ = (int)obid() - rot; if (c_ < 0) c_ += G_;
    pg8::Order S; S.init(skip ? 32 : 36, N, G_, c_, skip);
    pg8::Gemm g{A, Bt, MROWS, N, K, K};
    pg8::gemm_phase<Epi, pg8::Order, false>((PG8_LAS unsigned char*)shm, g, S, E, nullptr);
}
template <class Epi> DEV void run_gemm_ctxq(const bf16_t* A, const bf16_t* Bt, int N, int K, int q, const Epi& E) {
    const int G = (int)gridDim.x; int c = (int)obid() - 32 * q; if (c < 0) c += G;
    pg8::Order S; S.init(4, N, G, c, 2);
    pg8::Gemm g{A + (size_t)q * (K / 4), Bt + (size_t)q * (K / 4), MROWS, N, K / 4, K};
    pg8::gemm_phase<Epi, pg8::Order, false>((PG8_LAS unsigned char*)shm, g, S, E, nullptr);
}

DEV int mapcol(int mode, int n) {
    if (mode == 0) return n;
    if (mode == 1) return n < 5392 ? n : (n < 5632 ? -1 : n - 240);
    if (mode == 2) return 5904 + n;
    const int t = n >> 8, w = n & 255, half = w >> 7, j = w & 127;
    return half * (mode == 3 ? FFN : 512) + t * 128 + j;
}
DEV void tr_item(const float* W, int Nsrc, int K, bf16_t* WT, int nblk, int mode, int item, float* scr, int lane) {
    const int kb = item / nblk, nb = item - kb * nblk, k0 = 64 * kb, n0 = 64 * nb;
    const int n4 = (lane & 15) * 4, kr = lane >> 4;
    const int src = mapcol(mode, n0 + n4);
    const float* wp = W + (size_t)(k0 + kr) * Nsrc + src;
#pragma unroll 8
    for (int i = 0; i < 16; ++i) { f32x4 v = {0.f, 0.f, 0.f, 0.f};
        if (src >= 0) v = *(const f32x4*)(wp + (size_t)(4 * i) * Nsrc);
        float* d = scr + (4 * i + kr) * 65 + n4; d[0] = v[0]; d[1] = v[1]; d[2] = v[2]; d[3] = v[3]; }
    lds_wait();
    const int c = lane & 7;
#pragma unroll
    for (int j = 0; j < 8; ++j) { const int n = (lane >> 3) + 8 * j; const float* s = scr + (8 * c) * 65 + n;
        u32x4 o; o.x = pk2(s[0 * 65], s[1 * 65]); o.y = pk2(s[2 * 65], s[3 * 65]); o.z = pk2(s[4 * 65], s[5 * 65]); o.w = pk2(s[6 * 65], s[7 * 65]);
        st16(WT + (size_t)(n0 + n) * K + k0 + 8 * c, o); }
    lds_wait();
}
DEV void phase_convert(const KP& p, int l, int which, int chunk) {
    const int oz = opaque0();
    const int tid = otid(), wave = __builtin_amdgcn_readfirstlane(tid >> 6), lane = tid & 63;
    float* scr = (float*)shm + wave * (64 * 65);
    unsigned char* WB = wsp(p) + OFF_W;
    const int gw = obid() * 8 + wave, NGW = gridDim.x * 8;
    constexpr int I_WIN = 32 * (6144 / 64), I_WG = 32 * (8192 / 64), I_BA = 16 * 32, I_B5 = 8 * 32, I_WO = 32 * 32, I_FI = 32 * (11264 / 64), I_FO = 88 * 32, I_GL = 8 * 16;
    constexpr int I_LW = 8, I_LG = 16;
    constexpr int NIT = I_WIN + I_WG + I_BA + 3 * I_B5 + I_WO + I_FI + I_FO + I_GL + 4 * I_LW + I_LG;
    constexpr int N_A = I_WIN + I_WG + I_BA + 3 * I_B5 + I_WO, N_F = I_FI + I_FO;
    const int nloc = which == 0 ? NIT - N_F : (N_F + 127) / 128;
    for (int q = which == 0 ? gw : wave; q < nloc; q += which == 0 ? NGW : 8) {
        int it = which == 0 ? (q < N_A ? q : q + N_F) : N_A + chunk * ((N_F + 127) / 128) + q;
        if (which == 1 && it >= N_A + N_F) break;
        int r = it;
        if (r < I_WIN) { tr_item(p.in[oz + 8] + (size_t)l * 2048 * 14096, 14096, 2048, (bf16_t*)(WB + W_WIN), 6144 / 64, 1, r, scr, lane); continue; } r -= I_WIN;
        if (r < I_WG)  { tr_item(p.in[oz + 8] + (size_t)l * 2048 * 14096, 14096, 2048, (bf16_t*)(WB + W_WG), 8192 / 64, 2, r, scr, lane); continue; } r -= I_WG;
        if (r < I_BA)  { tr_item(p.in[oz + 36] + (size_t)l * 1024 * 2048, 2048, 1024, (bf16_t*)(WB + W_BA), 32, 0, r, scr, lane); continue; } r -= I_BA;
        if (r < I_B5)  { tr_item(p.in[oz + 37] + (size_t)l * 512 * 2048, 2048, 512, (bf16_t*)(WB + W_BR), 32, 0, r, scr, lane); continue; } r -= I_B5;
        if (r < I_B5)  { tr_item(p.in[oz + 38] + (size_t)l * 512 * 2048, 2048, 512, (bf16_t*)(WB + W_BM), 32, 0, r, scr, lane); continue; } r -= I_B5;
        if (r < I_B5)  { tr_item(p.in[oz + 39] + (size_t)l * 512 * 2048, 2048, 512, (bf16_t*)(WB + W_BS), 32, 0, r, scr, lane); continue; } r -= I_B5;
        if (r < I_WO)  { tr_item(p.in[oz + 40] + (size_t)l * 2048 * 2048, 2048, 2048, (bf16_t*)(WB + W_WO), 32, 0, r, scr, lane); continue; } r -= I_WO;
        if (r < I_FI)  { tr_item(p.in[oz + 41] + (size_t)l * 2048 * 11264, 11264, 2048, (bf16_t*)(WB + W_FI), 11264 / 64, 3, r, scr, lane); continue; } r -= I_FI;
        if (r < I_FO)  { tr_item(p.in[oz + 42] + (size_t)l * 5632 * 2048, 2048, 5632, (bf16_t*)(WB + W_FO), 32, 0, r, scr, lane); continue; } r -= I_FO;
        if (r < I_GL)  { tr_item(p.in[oz + 35] + (size_t)l * 512 * 1024, 1024, 512, (bf16_t*)(WB + W_GL), 16, 4, r, scr, lane); continue; } r -= I_GL;
        if (r < 4 * I_LW) { const int m = r >> 3;
            tr_item(p.in[oz + (m < 2 ? 14 : 16)] + (size_t)((l * 2 + (m & 1)) * 64) * 512, 512, 64, (bf16_t*)(WB + W_LW) + (size_t)m * 512 * 64, 8, 0, r & 7, scr, lane); continue; } r -= 4 * I_LW;
        tr_item(p.in[oz + 17] + (size_t)(l * 128) * 512, 512, 128, (bf16_t*)(WB + W_LW) + (size_t)4 * 512 * 64, 8, 0, r, scr, lane);
    }
}
DEV void phase_mod(const KP& p) {
    const int oz = opaque0();
    const int tid = otid(), wave = __builtin_amdgcn_readfirstlane(tid >> 6), lane = tid & 63;
    float* sc = (float*)shm; float* red = sc + 5 * 2048;
    __syncthreads();
    for (int i = tid; i < 5 * 2048; i += 512) { const int r = i >> 11, k = i & 2047; const float c = r < 4 ? p.in[oz + 1][r * 2048 + k] : p.in[oz + 3][k]; sc[i] = siluf(c); }
    __syncthreads();
    float* MOD = (float*)(wsp(p) + OFF_MOD);
    for (int it = obid(); it < 384; it += gridDim.x) {
        const int l = it / 192, cb = it - l * 192, col = cb * 64 + lane;
        const float* W = p.in[oz + 4] + (size_t)l * 2048 * 12288 + col;
        float a0 = 0.f, a1 = 0.f, a2 = 0.f, a3 = 0.f, a4 = 0.f;
#pragma unroll 8
        for (int k = wave * 256; k < wave * 256 + 256; ++k) { const float wv = W[(size_t)k * 12288];
            a0 += sc[k] * wv; a1 += sc[2048 + k] * wv; a2 += sc[4096 + k] * wv; a3 += sc[6144 + k] * wv; a4 += sc[8192 + k] * wv; }
        red[(wave * 5 + 0) * 64 + lane] = a0; red[(wave * 5 + 1) * 64 + lane] = a1; red[(wave * 5 + 2) * 64 + lane] = a2; red[(wave * 5 + 3) * 64 + lane] = a3; red[(wave * 5 + 4) * 64 + lane] = a4;
        __syncthreads();
        if (tid < 320) { const int r = tid >> 6; float s = 0.f;
#pragma unroll
            for (int w = 0; w < 8; ++w) s += red[(w * 5 + r) * 64 + lane];
            MOD[(size_t)(l * 5 + r) * 12288 + col] = s + p.in[oz + 5][l * 12288 + col]; }
        __syncthreads();
    }
}
DEV void phase_s5disc(const KP& p) {
    const int oz = opaque0();
    float* ABAR = (float*)(wsp(p) + OFF_ABAR); float* BBAR = (float*)(wsp(p) + OFF_BBAR);
    for (int gid = obid() * 512 + otid(); gid < 8192; gid += gridDim.x * 512) {
        const int ldg = gid >> 6;
        const float lre = p.in[oz + 27][gid], lim = p.in[oz + 28][gid], dt = expf(p.in[oz + 29][ldg]);
        const float mag = expf(lre * dt), ang = lim * dt, ar = mag * cosf(ang), ai = mag * sinf(ang);
        const float den = lre * lre + lim * lim;
        const float fr = ((ar - 1.f) * lre + ai * lim) / den, fi = (ai * lre - (ar - 1.f) * lim) / den;
        ABAR[gid * 2] = ar; ABAR[gid * 2 + 1] = ai;
#pragma unroll 4
        for (int c = 0; c < 16; ++c) { const float br = p.in[oz + 30][gid * 16 + c], bi = p.in[oz + 31][gid * 16 + c];
            BBAR[(gid * 16 + c) * 2] = fr * br - fi * bi; BBAR[(gid * 16 + c) * 2 + 1] = fr * bi + fi * br; }
    }
}
DEV void phase_norm(const KP& p, int l, int which, bool from_input, bool skipctx, int fold) {
    const int oz = opaque0();
    const int tid = otid(), wave = __builtin_amdgcn_readfirstlane(tid >> 6), lane = tid & 63;
    const int gw = obid() * 8 + wave, NGW = gridDim.x * 8;
    float* X = (float*)(wsp(p) + OFF_X); bf16_t* H = (bf16_t*)(wsp(p) + OFF_H);
    const float* MOD = (const float*)(wsp(p) + OFF_MOD);
    const float* gam = p.in[oz + (which ? 7 : 6)] + l * 2048;
    for (int row = gw; row < MROWS; row += NGW) {
        const int b = row / TPB, pp = row - b * TPB, mr = pp < 256 ? 4 : b;
        if (skipctx && pp < 256) continue;
        const float* src = from_input ? (pp < 256 ? p.in[oz + 2] + ((size_t)b * 256 + pp) * 2048 : p.in[oz + 0] + ((size_t)b * 2048 + (pp - 256)) * 2048) : X + (size_t)row * 2048;
        f32x4 v[8]; float ss = 0.f;
        const bool dofold = fold >= 0 && pp < 256;
#pragma unroll
        for (int j = 0; j < 8; ++j) { v[j] = ((const f32x4*)src)[lane + 64 * j];
            if (dofold) { const int c4 = lane + 64 * j; const bf16_t* pp_ = (const bf16_t*)(wsp(p) + OFF_PART) + ((size_t)(b * 256 + pp)) * 2048 + c4 * 4;
                f32x4 sacc = {0.f, 0.f, 0.f, 0.f};
#pragma unroll
                for (int q = 0; q < 4; ++q) { const u32x2 t = *(const u32x2*)(pp_ + (size_t)q * 1024 * 2048);
                    sacc[0] += __uint_as_float(t.x << 16); sacc[1] += __uint_as_float(t.x & 0xffff0000u); sacc[2] += __uint_as_float(t.y << 16); sacc[3] += __uint_as_float(t.y & 0xffff0000u); }
                const f32x4 gv = ((const f32x4*)(MOD + (size_t)((fold >> 3) * 5 + 4) * 12288 + (fold & 7) * 2048))[c4];
                v[j] += gv * sacc; ((f32x4*)(X + (size_t)row * 2048))[c4] = v[j]; }
            ss += v[j][0] * v[j][0] + v[j][1] * v[j][1] + v[j][2] * v[j][2] + v[j][3] * v[j][3]; }
        ss = wsum(ss);
        const float rs = 1.f / sqrtf(ss * (1.f / 2048.f) + 1e-6f);
        const float* shp = MOD + (size_t)(l * 5 + mr) * 12288 + (which ? 3 : 0) * 2048; const float* scp = shp + 2048;
#pragma unroll
        for (int j = 0; j < 8; ++j) { const int c4 = lane + 64 * j;
            if (from_input) ((f32x4*)(X + (size_t)row * 2048))[c4] = v[j];
            const f32x4 g = ((const f32x4*)gam)[c4], sh = ((const f32x4*)shp)[c4], sc = ((const f32x4*)scp)[c4];
            const f32x4 y = v[j] * rs * g; const f32x4 h = y * (sc + 1.f) + sh;
            u32x2 o; o.x = pk2(h[0], h[1]); o.y = pk2(h[2], h[3]); ((u32x2*)(H + (size_t)row * 2048))[c4] = o; }
    }
}
DEV void phase_final(const KP& p) {
    const int oz = opaque0();
    const int tid = otid(), wave = __builtin_amdgcn_readfirstlane(tid >> 6), lane = tid & 63;
    const int gw = obid() * 8 + wave, NGW = gridDim.x * 8;
    const float* X = (const float*)(wsp(p) + OFF_X); const float* gam = p.in[oz + 43];
    for (int r = gw; r < 8192; r += NGW) {
        const int b = r >> 11, t = r & 2047; const float* src = X + ((size_t)b * TPB + 256 + t) * 2048;
        f32x4 v[8]; float ss = 0.f;
#pragma unroll
        for (int j = 0; j < 8; ++j) { v[j] = ((const f32x4*)src)[lane + 64 * j]; ss += v[j][0] * v[j][0] + v[j][1] * v[j][1] + v[j][2] * v[j][2] + v[j][3] * v[j][3]; }
        ss = wsum(ss);
        const float rs = 1.f / sqrtf(ss * (1.f / 2048.f) + 1e-6f);
#pragma unroll
        for (int j = 0; j < 8; ++j) { const int c4 = lane + 64 * j; ((f32x4*)(p.out + (size_t)r * 2048))[c4] = v[j] * rs * ((const f32x4*)gam)[c4]; }
    }
}
DEV void phase_attnprep(const KP& p, int l) {
    const int oz = opaque0();
    const int tid = otid(), wave = __builtin_amdgcn_readfirstlane(tid >> 6), lane = tid & 63;
    const int gw = obid() * 8 + wave, NGW = gridDim.x * 8;
    bf16_t* ZA = (bf16_t*)(wsp(p) + OFF_ZA);
    const float* qg = p.in[oz + 10] + l * 128; const float* kg = p.in[oz + 11] + l * 128;
    const float qg0 = qg[lane], qg1 = qg[64 + lane], kg0 = kg[lane], kg1 = kg[64 + lane];
    const float invf = exp2f(-(float)(lane & 31) * (13.287712379549449f / 32.f));
    for (int row = gw; row < MROWS; row += NGW) {
        bf16_t* z = ZA + (size_t)row * LD_ZA; const int pp = row % TPB; const bool lat = pp >= 256; const int t = pp - 256;
        float cr = 1.f, sr = 0.f, cc = 1.f, scn = 0.f;
        if (lat) { const float a1 = (float)(t >> 6) * invf, a2 = (float)(t & 63) * invf; cr = __cosf(a1); sr = __sinf(a1); cc = __cosf(a2); scn = __sinf(a2); }
#pragma unroll
        for (int j = 0; j < 10; ++j) {
            const float v0 = bf2f(z[j * 128 + lane]), v1 = bf2f(z[j * 128 + 64 + lane]);
            const float ss = wsum(v0 * v0 + v1 * v1); const float rs = 1.f / sqrtf(ss * (1.f / 128.f) + 1e-6f);
            float y0 = v0 * rs * (j < 8 ? qg0 : kg0), y1 = v1 * rs * (j < 8 ? qg1 : kg1);
            if (lat) { const float p0 = __shfl_xor(y0, 32), p1 = __shfl_xor(y1, 32);
                if (lane < 32) { y0 = y0 * cr - p0 * sr; y1 = y1 * cc - p1 * scn; } else { y0 = p0 * sr + y0 * cr; y1 = p1 * scn + y1 * cc; } }
            z[j * 128 + lane] = f2bf(y0); z[j * 128 + 64 + lane] = f2bf(y1);
        }
    }
}
DEV float shiftz(const float* ZF, int row, int col, float mu) {
    const int pp = row % TPB; const float* zp = ZF + (size_t)row * LD_ZF + col; const float z = zp[0];
    const float zl = (pp != 0 && pp != 256) ? zp[-LD_ZF] : 0.f, zr = (pp != 255 && pp != 2303) ? zp[LD_ZF] : 0.f;
    return z + mu * (0.5f * (zl + zr) - z);
}
DEV void phase_rwkvprep(const KP& p, int l) {
    const int oz = opaque0();
    const int tid = otid(), wave = __builtin_amdgcn_readfirstlane(tid >> 6), lane = tid & 63, j = tid;
    bf16_t* Xs = (bf16_t*)shm;
    float* outs = (float*)(shm + 16 * 264 * 2);
    const float* ZF = (const float*)(wsp(p) + OFF_ZF);
    float* RW = (float*)(wsp(p) + OFF_RW); float* C12 = (float*)(wsp(p) + OFF_C12);
    const bf16_t* LW = (const bf16_t*)(wsp(p) + OFF_W + W_LW);
    const float* mu = p.in[oz + 12] + l * 1792;
    const float w00 = p.in[oz + 13][(l * 2 + 0) * 512 + j], w01 = p.in[oz + 13][(l * 2 + 1) * 512 + j], a00 = p.in[oz + 15][(l * 2 + 0) * 512 + j], a01 = p.in[oz + 15][(l * 2 + 1) * 512 + j];
    const float kkc = p.in[oz + 18][l * 512 + j], kac = p.in[oz + 19][l * 512 + j], rkc = p.in[oz + 20][l * 512 + j], mu_r = mu[j], mu_k = mu[512 + j], mu_v = mu[1024 + j];
    __syncthreads();
    for (int e = tid; e < 8 * 264; e += 512) Xs[8 * 264 + e] = 0;
    for (int it = obid(); it < 1152; it += gridDim.x) {
        const int row0 = it * 8;
        __syncthreads();
        for (int e = tid; e < 8 * 256; e += 512) { const int t = e >> 8, cc = e & 255; const float z = shiftz(ZF, row0 + t, 1536 + cc, mu[1536 + cc]);
            Xs[t * 264 + cc] = f2bf(cc < 64 ? tanhf(z) : (cc < 128 ? z : sigm(z))); }
        __syncthreads();
        { const int lr = lane & 15, lq4 = lane >> 4;
#pragma unroll 1
            for (int t4 = 0; t4 < 4; ++t4) { const int col = wave * 64 + t4 * 16 + lr;
#pragma unroll
                for (int m = 0; m < 5; ++m) { const int K = m < 4 ? 64 : 128, xoff = m < 2 ? 0 : (m < 4 ? 64 : 128);
                    const bf16_t* WT = LW + (size_t)(m < 4 ? m * 512 * 64 : 4 * 512 * 64) + (size_t)col * K + 8 * lq4;
                    pg8::f32x4 acc = {0.f, 0.f, 0.f, 0.f};
#pragma unroll
                    for (int ks = 0; ks < K / 32; ++ks) { const bf16x8 a = *(const bf16x8*)(Xs + lr * 264 + xoff + 32 * ks + 8 * lq4), bq = *(const bf16x8*)(WT + 32 * ks);
                        acc = __builtin_amdgcn_mfma_f32_16x16x32_bf16(a, bq, acc, 0, 0, 0); }
                    if (lq4 < 2) {
#pragma unroll
                        for (int i = 0; i < 4; ++i) outs[(m * 8 + 4 * lq4 + i) * 512 + col] = acc[i]; } } } }
        __syncthreads();
        float zr[10], zk[10], zv[10];
        { const int pp0 = row0 % TPB; const bool hasL = pp0 != 0 && pp0 != 256, hasR = (pp0 + 7) != 255 && (pp0 + 7) != 2303;
#pragma unroll
            for (int i = 0; i < 10; ++i) { const bool ok = i == 0 ? hasL : (i == 9 ? hasR : true); const float* zp = ZF + (size_t)(row0 - 1 + i) * LD_ZF + j;
                zr[i] = ok ? zp[0] : 0.f; zk[i] = ok ? zp[512] : 0.f; zv[i] = ok ? zp[1024] : 0.f; } }
#pragma unroll
        for (int t = 0; t < 8; ++t) {
            const int row = row0 + t; const size_t o = (size_t)row * 512 + j;
            const float r = zr[t + 1] + mu_r * (0.5f * (zr[t] + zr[t + 2]) - zr[t + 1]), k = zk[t + 1] + mu_k * (0.5f * (zk[t] + zk[t + 2]) - zk[t + 1]), v = zv[t + 1] + mu_v * (0.5f * (zv[t] + zv[t + 2]) - zv[t + 1]);
            const float kkr = k * kkc; const float ss = wsum(kkr * kkr); const float kk = kkr * (1.f / sqrtf(ss + 1e-12f));
            RW[0 * SZ_RW + o] = r; RW[1 * SZ_RW + o] = v; RW[2 * SZ_RW + o] = kk; RW[9 * SZ_RW + o] = outs[(4 * 8 + t) * 512 + j];
#pragma unroll
            for (int d = 0; d < 2; ++d) {
                const float wpre = (d ? w01 : w00) + outs[((d ? 1 : 0) * 8 + t) * 512 + j];
                const float w = __expf(-0.6065306597126334f * sigm(wpre));
                const float a = sigm((d ? a01 : a00) + outs[((d ? 3 : 2) * 8 + t) * 512 + j]);
                const float km = k * (1.f + (a - 1.f) * kac), bb = a * kk;
                const float c1 = wsum(bb * r), c2 = wsum(r * km * (1.f + rkc));
                RW[(3 + d) * SZ_RW + o] = w; RW[(5 + d) * SZ_RW + o] = bb; RW[(7 + d) * SZ_RW + o] = km;
                if (lane == 0) { float* cp = C12 + (((size_t)d * MROWS + row) * 8 + wave) * 2; cp[0] = c1; cp[1] = c2; }
            }
        }
    }
}

template <int CTRL> DEV float dpp_f(float v) { return __builtin_bit_cast(float, __builtin_amdgcn_update_dpp(0, __builtin_bit_cast(int, v), CTRL, 0xF, 0xF, true)); }
#define dpp_f(v, ctrl) dpp_f<ctrl>(v)
DEV void rwkv_scan(const KP& p, int sid, int half) {
    const int oz = opaque0();
    const int b = sid >> 4, h = (sid >> 1) & 7, d = sid & 1;
    const int tid = otid(), wave = __builtin_amdgcn_readfirstlane(tid >> 6), lane = tid & 63, rp = lane >> 4, kq = lane & 15;
    const int row0 = half * 32 + wave * 4 + rp;
    float* buf = (float*)shm;
    float* olds = buf + 16 * 400;
    const float* RW = (const float*)(wsp(p) + OFF_RW);
    const float* C12 = (const float*)(wsp(p) + OFF_C12) + (size_t)d * MROWS * 16;
    float* ORW = (float*)(wsp(p) + OFF_SC) + (size_t)d * SZ_RW;
    const int lstep = tid >> 5, lq = tid & 31;
    f32x4 S0 = {0.f, 0.f, 0.f, 0.f};
    f32x4 st0, st1, st2; f32x2 cst = {0.f, 0.f};
#define RWK_SRC(e_, row_) (RW + (size_t)((((e_) >> 4) == 0) ? 3 + d : (((e_) >> 4) == 1) ? 2 : (((e_) >> 4) == 2) ? 5 + d : (((e_) >> 4) == 3) ? 7 + d : (((e_) >> 4) == 4) ? 0 : 1) * SZ_RW + (size_t)(row_) * 512 + h * 64 + ((e_) & 15) * 4)
#define RWK_ISSUE(chunk_) do { const int row_ = b * TPB + seqpos((chunk_) * 16 + lstep, d); \
        st0 = *(const f32x4*)RWK_SRC(lq, row_); st1 = *(const f32x4*)RWK_SRC(lq + 32, row_); st2 = *(const f32x4*)RWK_SRC(lq + 64, row_); \
        if (lq == 0) cst = *(const f32x2*)(C12 + ((size_t)row_ * 8 + h) * 2); } while (0)
#define RWK_COMMIT() do { float* bp_ = buf + lstep * 400; *(f32x4*)(bp_ + lq * 4) = st0; *(f32x4*)(bp_ + (lq + 32) * 4) = st1; *(f32x4*)(bp_ + (lq + 64) * 4) = st2; \
        if (lq == 0) { bp_[384] = cst[0]; bp_[385] = cst[1]; } } while (0)
    __syncthreads();
    RWK_ISSUE(0); RWK_COMMIT();
    __syncthreads();
    const float* __restrict__ rbuf = buf;
#pragma unroll 1
    for (int c = 0; c < 144; ++c) {
        if (c + 1 < 144) RWK_ISSUE(c + 1);
        {
        float osel0 = 0.f;
#define RW_LOAD(st_, W, K, B, M, R, V, C) do { const float* sp_ = rbuf + (st_) * 400 + kq * 4; W = *(const f32x4*)(sp_); K = *(const f32x4*)(sp_ + 64); B = *(const f32x4*)(sp_ + 128); \
            M = *(const f32x4*)(sp_ + 192); R = *(const f32x4*)(sp_ + 256); V = rbuf[(st_) * 400 + 320 + row0]; C = *(const f32x2*)(rbuf + (st_) * 400 + 384); } while (0)
#define RW_STEP(st_, W, K, B, M, R, V, C) do { \
            const f32x4 p0 = S0 * K, wr = W * R; const f32x4 q0 = S0 * wr; \
            float sa0 = (p0[0] + p0[1]) + (p0[2] + p0[3]); \
            float so0 = (q0[0] + q0[1]) + (q0[2] + q0[3]); \
            const f32x4 t0 = M * V; \
            sa0 += dpp_f(sa0, 0xB1); sa0 += dpp_f(sa0, 0x4E); sa0 += dpp_f(sa0, 0x141); sa0 += dpp_f(sa0, 0x140); \
            S0 = S0 * W + (t0 - B * sa0); \
            so0 += dpp_f(so0, 0xB1); so0 += dpp_f(so0, 0x4E); so0 += dpp_f(so0, 0x141); so0 += dpp_f(so0, 0x140); \
            const float o0 = so0 - sa0 * C[0] + V * C[1]; \
            osel0 = (kq == (st_)) ? o0 : osel0; } while (0)
        f32x4 aw, ak, ab, am, ar, bw, bk, bb, bm, br; f32x2 ac, bc; float av, bv;
        RW_LOAD(0, aw, ak, ab, am, ar, av, ac);
#pragma unroll
        for (int s2 = 0; s2 < 16; s2 += 2) {
            RW_LOAD(s2 + 1, bw, bk, bb, bm, br, bv, bc);
            __builtin_amdgcn_sched_barrier(0);
            RW_STEP(s2, aw, ak, ab, am, ar, av, ac);
            if (s2 + 2 < 16) RW_LOAD(s2 + 2, aw, ak, ab, am, ar, av, ac);
            __builtin_amdgcn_sched_barrier(0);
            RW_STEP(s2 + 1, bw, bk, bb, bm, br, bv, bc);
        }
#undef RW_LOAD
#undef RW_STEP
        olds[kq * 64 + row0] = osel0;
        }
        __syncthreads();
        if ((lq >> 4) == half) { const int row_ = b * TPB + seqpos(c * 16 + lstep, d); *(f32x2*)(ORW + (size_t)row_ * 512 + h * 64 + lq * 2) = *(const f32x2*)(olds + lstep * 64 + lq * 2); }
        if (c + 1 < 144) RWK_COMMIT();
        __syncthreads();
    }
#undef RWK_SRC
#undef RWK_ISSUE
#undef RWK_COMMIT
}

DEV f32x16 mfma32(bf16x8 a, bf16x8 b, f32x16 c) { return __builtin_amdgcn_mfma_f32_32x32x16_bf16(a, b, c, 0, 0, 0); }
DEV void mlstm_scan(const KP& p, int l, int mid) {
    const int oz = opaque0();
    const int b = mid >> 4, h = (mid >> 2) & 3, d = (mid >> 1) & 1, vbase = (mid & 1) * 64;
    const int tid = otid(), wave = __builtin_amdgcn_readfirstlane(tid >> 6), lane = tid & 63, r32 = lane & 31, hi = lane >> 5;
    bf16_t* Qc = (bf16_t*)shm;
    bf16_t* Kc = Qc + 64 * 136;
    bf16_t* KcT = Kc + 64 * 136;
    bf16_t* VT = KcT + 128 * 72;
    bf16_t* VsT = VT + 64 * 72;
    bf16_t* Sm = VsT + 64 * 72;
    bf16_t* Cb = Sm + 64 * 72;
    float* fl = (float*)(Cb + 64 * 136);
    float* gS = fl, *MtS = fl + 64, *srcS = fl + 128, *winS = fl + 192, *emtS = fl + 256, *nvec = fl + 320, *rsp = fl + 448, *nqp = fl + 576, *dnw = fl + 1088, *cw = fl + 1344;
    bf16_t* Ql = (bf16_t*)(fl + 2112);
    bf16_t* Kl = Ql + 64 * 136;
    const float* ZF = (const float*)(wsp(p) + OFF_ZF);
    float* HM = (float*)(wsp(p) + OFF_SC) + (size_t)(2 + d) * SZ_RW;
    const float ib = p.in[oz + 24][l * 8 + d * 4 + h], fb = p.in[oz + 25][l * 8 + d * 4 + h];
    __syncthreads();
    for (int e = tid; e < 64 * 136; e += 512) Cb[e] = 0;
    if (tid < 128) nvec[tid] = 0.f;
    for (int e = tid; e < 768; e += 512) { const int jj = e >> 8, c = e & 255; cw[e] = p.in[oz + 23][(size_t)(l * 3 + jj) * 1024 + (c < 128 ? h * 128 + c : 512 + h * 128 + (c - 128))]; }
    __syncthreads();
    f32x16 accC;
#pragma unroll
    for (int r = 0; r < 16; ++r) accC[r] = 0.f;
    float m = 0.f;
    const int ti = tid >> 3, cg8 = tid & 7;
#pragma unroll 1
    for (int c = 0; c < 36; ++c) {
        const int rowi = b * TPB + seqpos(64 * c + lane, d);
        const float igv = ZF[(size_t)rowi * LD_ZF + ZF_MLG + d * 4 + h] + ib, fgv = ZF[(size_t)rowi * LD_ZF + ZF_MLG + 8 + d * 4 + h] + fb;
        const float lf = fgv > 0.f ? -log1pf(__expf(-fgv)) : fgv - log1pf(__expf(fgv));
        float cum = lf;
#pragma unroll
        for (int o = 1; o < 64; o <<= 1) { const float t = __shfl_up(cum, o); if (lane >= o) cum += t; }
        const float g = igv - cum; float pm = g;
#pragma unroll
        for (int o = 1; o < 64; o <<= 1) { const float t = __shfl_up(pm, o); if (lane >= o) pm = fmaxf(pm, t); }
        const float Mt = fmaxf(pm, m), M63 = __shfl(Mt, 63), total = __shfl(cum, 63);
        const float src = __expf(g - M63), decay = __expf(m - M63), win = __expf(m - Mt), emt = __expf(-(cum + Mt));
        if (wave == 0) { gS[lane] = g; MtS[lane] = Mt; srcS[lane] = src; winS[lane] = win; emtS[lane] = emt; }
        const float m_next = total + M63;
        {
            const int pT = seqpos(64 * c + ti, d); const size_t rowT = (size_t)b * TPB + pT;
            const bool hasL = (pT != 0 && pT != 256), hasR = (pT != 255 && pT != 2303);
            const float* zc = ZF + rowT * LD_ZF + ZF_ML;
            const float srcT = __shfl(src, ti);
#pragma unroll
            for (int part = 0; part < 2; ++part) {
                const float* base = zc + part * 512 + h * 128 + 16 * cg8;
#pragma unroll
                for (int v4 = 0; v4 < 4; ++v4) {
                    const f32x4 zm = *(const f32x4*)(base + 4 * v4);
                    f32x4 zl = {0.f, 0.f, 0.f, 0.f}, zr = {0.f, 0.f, 0.f, 0.f};
                    if (hasL) zl = *(const f32x4*)(base - LD_ZF + 4 * v4);
                    if (hasR) zr = *(const f32x4*)(base + LD_ZF + 4 * v4);
                    const int cc = part * 128 + 16 * cg8 + 4 * v4;
                    const f32x4 w0 = *(const f32x4*)(cw + cc), w1 = *(const f32x4*)(cw + 256 + cc), w2 = *(const f32x4*)(cw + 512 + cc);
                    f32x4 val = zl * w0 + zm * w1 + zr * w2;
#pragma unroll
                    for (int i = 0; i < 4; ++i) val[i] = siluf(val[i]) * (part ? 0.08838834764831845f : 1.f);
                    u32x2 o; o.x = pk2(val[0], val[1]); o.y = pk2(val[2], val[3]);
                    const int ch = 16 * cg8 + 4 * v4;
                    if (part == 0) { *(u32x2*)(Qc + ti * 136 + ch) = o; }
                    else { *(u32x2*)(Kc + ti * 136 + ch) = o;
                        KcT[(ch + 0) * 72 + ti] = (bf16_t)(o.x & 0xffffu); KcT[(ch + 1) * 72 + ti] = (bf16_t)(o.x >> 16); KcT[(ch + 2) * 72 + ti] = (bf16_t)(o.y & 0xffffu); KcT[(ch + 3) * 72 + ti] = (bf16_t)(o.y >> 16); }
                }
            }
            const float* vsrc = zc + 1024 + h * 128 + vbase + 8 * cg8;
#pragma unroll
            for (int v4 = 0; v4 < 2; ++v4) { const f32x4 vv = *(const f32x4*)(vsrc + 4 * v4);
#pragma unroll
                for (int i = 0; i < 4; ++i) { const int vc = 8 * cg8 + 4 * v4 + i; VT[vc * 72 + ti] = f2bf(vv[i]); VsT[vc * 72 + ti] = f2bf(vv[i] * srcT); } }
        }
        __syncthreads();
        f32x16 acc2;
#pragma unroll
        for (int r = 0; r < 16; ++r) acc2[r] = 0.f;
        const int w4 = wave - 4, tt2 = (w4 >> 1) & 1, vt = w4 & 1;
        if (wave < 4) {
            const int st = wave & 1, tt = wave >> 1;
            f32x16 acc;
#pragma unroll
            for (int r = 0; r < 16; ++r) acc[r] = 0.f;
            if (!(st == 1 && tt == 0)) {
#pragma unroll
                for (int kk = 0; kk < 8; ++kk) { const int ao = (32 * st + r32) * 136 + 16 * kk + 8 * hi, bo = (32 * tt + r32) * 136 + 16 * kk + 8 * hi;
                    const bf16x8 a = *(const bf16x8*)(Kc + ao), bq = *(const bf16x8*)(Qc + bo);
                    acc = mfma32(a, bq, acc); }
            }
            const int t = 32 * tt + r32; const float Mtt = MtS[t]; float psum = 0.f;
#pragma unroll
            for (int r4 = 0; r4 < 4; ++r4) { float vals[4];
#pragma unroll
                for (int i = 0; i < 4; ++i) { const int r = r4 * 4 + i, s = 32 * st + crow16(r, hi); const float dv = (s <= t) ? __expf(gS[s] - Mtt) : 0.f; vals[i] = acc[r] * dv; psum += vals[i]; }
                u32x2 o; o.x = pk2(vals[0], vals[1]); o.y = pk2(vals[2], vals[3]); *(u32x2*)(Sm + t * 72 + 32 * st + 8 * r4 + 4 * hi) = o; }
            psum += __shfl_xor(psum, 32);
            if (hi == 0) rsp[st * 64 + t] = psum;
        } else {
#pragma unroll
            for (int kk = 0; kk < 8; ++kk) { const bf16x8 a = *(const bf16x8*)(Qc + (32 * tt2 + r32) * 136 + 16 * kk + 8 * hi), bb = *(const bf16x8*)(Cb + (32 * vt + r32) * 136 + 16 * kk + 8 * hi);
                acc2 = mfma32(a, bb, acc2); }
        }
        { const int t = tid & 63, part = tid >> 6; float s = 0.f;
#pragma unroll
            for (int k = 0; k < 16; ++k) s += nvec[part * 16 + k] * bf2f(Qc[t * 136 + part * 16 + k]);
            nqp[part * 64 + t] = s; }
        __syncthreads();
        if (wave >= 4) {
            float den = rsp[lane] + rsp[64 + lane]; float nq = 0.f;
#pragma unroll
            for (int part = 0; part < 8; ++part) nq += nqp[part * 64 + lane];
            den += winS[lane] * nq;
            float* my = dnw + w4 * 64; my[lane] = 1.f / fmaxf(fabsf(den), emtS[lane]); lds_wait();
#pragma unroll
            for (int r = 0; r < 16; ++r) acc2[r] *= winS[32 * tt2 + crow16(r, hi)];
#pragma unroll
            for (int kk = 0; kk < 4; ++kk) { const bf16x8 a = *(const bf16x8*)(Sm + (32 * tt2 + r32) * 72 + 16 * kk + 8 * hi), bb = *(const bf16x8*)(VT + (32 * vt + r32) * 72 + 16 * kk + 8 * hi);
                acc2 = mfma32(a, bb, acc2); }
#pragma unroll
            for (int r = 0; r < 16; ++r) { const int t = 32 * tt2 + crow16(r, hi); const int pT = seqpos(64 * c + t, d);
                HM[((size_t)b * TPB + pT) * 512 + h * 128 + vbase + 32 * vt + r32] = acc2[r] * my[t]; }
        } else if (wave < 2) {
            float s = 0.f;
#pragma unroll 8
            for (int si = 0; si < 64; ++si) s += srcS[si] * bf2f(KcT[tid * 72 + si]);
            nvec[tid] = decay * nvec[tid] + s;
        }
        { const int kt = wave & 3, vt2 = wave >> 2;
#pragma unroll
            for (int r = 0; r < 16; ++r) accC[r] *= decay;
#pragma unroll
            for (int kk = 0; kk < 4; ++kk) { const bf16x8 a = *(const bf16x8*)(KcT + (32 * kt + r32) * 72 + 16 * kk + 8 * hi), bb = *(const bf16x8*)(VsT + (32 * vt2 + r32) * 72 + 16 * kk + 8 * hi);
                accC = mfma32(a, bb, accC); }
#pragma unroll
            for (int r4 = 0; r4 < 4; ++r4) { u32x2 o; o.x = pk2(accC[r4 * 4 + 0], accC[r4 * 4 + 1]); o.y = pk2(accC[r4 * 4 + 2], accC[r4 * 4 + 3]);
                *(u32x2*)(Cb + (32 * vt2 + r32) * 136 + 32 * kt + 8 * r4 + 4 * hi) = o; } }
        m = m_next;
        __syncthreads();
    }
}

DEV void s5_scan(const KP& p, int l, int sid) {
    const int oz = opaque0();
    const int b = sid >> 6, g = (sid >> 1) & 31, d = sid & 1;
    const int tid = otid(), wave = __builtin_amdgcn_readfirstlane(tid >> 6), lane = tid & 63;
    float* CRs = (float*)shm; float* CIs = CRs + 1024; float* Fs = CIs + 1024;
    float* us = Fs + 1024 + wave * (256 + 2 * 16 * 65); float* xsr = us + 256; float* xsi = xsr + 16 * 65;
    const int ldg = (l * 2 + d) * 32 + g, gid = ldg * 64 + lane;
    const float* ABAR = (const float*)(wsp(p) + OFF_ABAR); const float* BBAR = (const float*)(wsp(p) + OFF_BBAR);
    const float* ZF = (const float*)(wsp(p) + OFF_ZF);
    float* YS = (float*)(wsp(p) + OFF_SC) + (size_t)(4 + d) * SZ_RW;
    const float ar = ABAR[gid * 2], ai = ABAR[gid * 2 + 1];
    const int lt = lane & 15, lq = lane >> 4;
    bf16x8 B1[8], B2[8];
#pragma unroll
    for (int j = 0; j < 8; ++j) { const float* bp = BBAR + ((size_t)(ldg * 64 + 16 * (j & 3) + lt) * 16 + 8 * (lq & 1)) * 2 + (j >> 2);
        float bv[8];
#pragma unroll
        for (int i = 0; i < 8; ++i) bv[i] = bp[2 * i];
        u32x4 hi; hi.x = pk2(bv[0], bv[1]); hi.y = pk2(bv[2], bv[3]); hi.z = pk2(bv[4], bv[5]); hi.w = pk2(bv[6], bv[7]);
        u32x4 lo; lo.x = pk2(bv[0] - __uint_as_float(hi.x << 16), bv[1] - __uint_as_float(hi.x & 0xffff0000u)); lo.y = pk2(bv[2] - __uint_as_float(hi.y << 16), bv[3] - __uint_as_float(hi.y & 0xffff0000u));
        lo.z = pk2(bv[4] - __uint_as_float(hi.z << 16), bv[5] - __uint_as_float(hi.z & 0xffff0000u)); lo.w = pk2(bv[6] - __uint_as_float(hi.w << 16), bv[7] - __uint_as_float(hi.w & 0xffff0000u));
        if (lq >= 2) lo = (u32x4){0u, 0u, 0u, 0u};
        B1[j] = __builtin_bit_cast(bf16x8, hi); B2[j] = __builtin_bit_cast(bf16x8, lo); }
    float* buf = xsr;
    __syncthreads();
    for (int e = tid; e < 1024; e += 512) { const int c = e >> 6, pp = e & 63; CRs[pp * 16 + c] = p.in[oz + 32][(size_t)ldg * 1024 + e]; CIs[pp * 16 + c] = -p.in[oz + 33][(size_t)ldg * 1024 + e]; }
    const int s0w = wave * 288, lstep = lane >> 2, lpart = lane & 3;
#define S5_LOADU(sub_) (*(const f32x4*)(ZF + ((size_t)b * TPB + seqpos(s0w + (sub_) * 16 + lstep, d)) * LD_ZF + ZF_S5 + g * 16 + lpart * 4))
#define S5_BU() do { const f32x4 ua_ = *(const f32x4*)(us + lt * 16 + 8 * (lq & 1)), ub_ = *(const f32x4*)(us + lt * 16 + 8 * (lq & 1) + 4); \
        u32x4 hi_; hi_.x = pk2(ua_[0], ua_[1]); hi_.y = pk2(ua_[2], ua_[3]); hi_.z = pk2(ub_[0], ub_[1]); hi_.w = pk2(ub_[2], ub_[3]); \
        u32x4 lo_; lo_.x = pk2(ua_[0] - __uint_as_float(hi_.x << 16), ua_[1] - __uint_as_float(hi_.x & 0xffff0000u)); lo_.y = pk2(ua_[2] - __uint_as_float(hi_.y << 16), ua_[3] - __uint_as_float(hi_.y & 0xffff0000u)); \
        lo_.z = pk2(ub_[0] - __uint_as_float(hi_.z << 16), ub_[1] - __uint_as_float(hi_.z & 0xffff0000u)); lo_.w = pk2(ub_[2] - __uint_as_float(hi_.w << 16), ub_[3] - __uint_as_float(hi_.w & 0xffff0000u)); \
        const bf16x8 A1_ = __builtin_bit_cast(bf16x8, lq < 2 ? hi_ : lo_), A2_ = __builtin_bit_cast(bf16x8, lq < 2 ? hi_ : (u32x4){0u, 0u, 0u, 0u}); \
        _Pragma("unroll") for (int j_ = 0; j_ < 8; ++j_) { pg8::f32x4 d_ = {0.f, 0.f, 0.f, 0.f}; \
            d_ = __builtin_amdgcn_mfma_f32_16x16x32_bf16(A1_, B1[j_], d_, 0, 0, 0); d_ = __builtin_amdgcn_mfma_f32_16x16x32_bf16(A2_, B2[j_], d_, 0, 0, 0); \
            _Pragma("unroll") for (int r_ = 0; r_ < 4; ++r_) buf[(4 * lq + r_) * 130 + 16 * j_ + lt] = d_[r_]; } \
        lds_wait(); } while (0)
#define S5_STEP(step_) do { const float bre_ = buf[(step_) * 130 + lane], bim_ = buf[(step_) * 130 + 64 + lane]; \
        const float nxr_ = ar * xr - ai * xi + bre_, nxi_ = ar * xi + ai * xr + bim_; xr = nxr_; xi = nxi_; } while (0)
    float xr = 0.f, xi = 0.f;
    f32x4 un = S5_LOADU(0);
#pragma unroll 1
    for (int sub = 0; sub < 18; ++sub) {
        lds_wait(); *(f32x4*)(us + lane * 4) = un; lds_wait();
        if (sub + 1 < 18) un = S5_LOADU(sub + 1);
        S5_BU();
#pragma unroll 4
        for (int step = 0; step < 16; ++step) S5_STEP(step);
    }
    Fs[(wave * 64 + lane) * 2] = xr; Fs[(wave * 64 + lane) * 2 + 1] = xi;
    __syncthreads();
    { float pr = ar, pi = ai, qr = 0.f, qi = 0.f;
#pragma unroll
        for (int i = 0; i < 8; ++i) { const float nr = pr * pr - pi * pi, ni = 2.f * pr * pi; pr = nr; pi = ni; if (i == 4) { qr = pr; qi = pi; } }
        const float er = pr * qr - pi * qi, ei = pr * qi + pi * qr;
        xr = 0.f; xi = 0.f;
        for (int w = 0; w < wave; ++w) { const float fr = Fs[(w * 64 + lane) * 2], fi = Fs[(w * 64 + lane) * 2 + 1]; const float nr = er * xr - ei * xi + fr, ni = er * xi + ei * xr + fi; xr = nr; xi = ni; } }
    float cbr[16], cbi[16];
#pragma unroll
    for (int ks = 0; ks < 16; ++ks) { cbr[ks] = CRs[(4 * ks + (lane >> 4)) * 16 + (lane & 15)]; cbi[ks] = CIs[(4 * ks + (lane >> 4)) * 16 + (lane & 15)]; }
    un = S5_LOADU(0);
#pragma unroll 1
    for (int sub = 0; sub < 18; ++sub) {
        lds_wait(); *(f32x4*)(us + lane * 4) = un; lds_wait();
        if (sub + 1 < 18) un = S5_LOADU(sub + 1);
        S5_BU();
#pragma unroll 4
        for (int step = 0; step < 16; ++step) { S5_STEP(step); buf[step * 130 + lane] = xr; buf[step * 130 + 65 + lane] = xi; }
        lds_wait();
        f32x4 acr = {0.f, 0.f, 0.f, 0.f}, aci = {0.f, 0.f, 0.f, 0.f};
#pragma unroll
        for (int ks = 0; ks < 16; ++ks) { const float a1 = buf[(lane & 15) * 130 + 4 * ks + (lane >> 4)], a2 = buf[(lane & 15) * 130 + 65 + 4 * ks + (lane >> 4)];
            acr = __builtin_amdgcn_mfma_f32_16x16x4f32(a1, cbr[ks], acr, 0, 0, 0); aci = __builtin_amdgcn_mfma_f32_16x16x4f32(a2, cbi[ks], aci, 0, 0, 0); }
        const f32x4 acc = acr + aci;
#pragma unroll
        for (int r = 0; r < 4; ++r) YS[((size_t)b * TPB + seqpos(s0w + sub * 16 + 4 * (lane >> 4) + r, d)) * 512 + g * 16 + (lane & 15)] = acc[r];
    }
#undef S5_LOADU
#undef S5_STEP
#undef S5_BU
}

DEV void attn_unit(const KP& p, int b, int hq, int qrow0, int nkeys) {
    const int oz = opaque0();
    const att::bf16* ZA = (const att::bf16*)(wsp(p) + OFF_ZA); att::bf16* O = (att::bf16*)(wsp(p) + OFF_O);
    const size_t base = (size_t)b * TPB; const int kvh = hq >> 2;
    __syncthreads();
    att::attn_dense_body<att::bf16>(ZA + (base + qrow0) * LD_ZA + hq * 128, ZA + base * LD_ZA + 1024 + kvh * 128, ZA + base * LD_ZA + 1280 + kvh * 128,
                                    O + (base + qrow0) * 1024 + hq * 128, nkeys, (char*)shm);
    __syncthreads();
}
DEV void phase_mix(const KP& p, int l) {
    const int oz = opaque0();
    unsigned* ctr = (unsigned*)(wsp(p) + OFF_BAR + 14336) + 16 * l;
    volatile int* slot = (volatile int*)(shm + XBST_OFF + 16);
    const int NA = l == 0 ? 736 : 704, NT = NA + 128;
#pragma unroll 1
    for (;;) {
        __syncthreads();
        if (otid() == 0) *slot = (int)__hip_atomic_fetch_add(ctr, 1u, __ATOMIC_RELAXED, __HIP_MEMORY_SCOPE_AGENT);
        __syncthreads();
        const int t = __builtin_amdgcn_readfirstlane(*slot);
        if (t >= NT) break;
        if (t < 128) rwkv_scan(p, t >> 1, t & 1);
        else if (t < 192) mlstm_scan(p, l, t - 128);
        else if (t < 448) s5_scan(p, l, t - 192);
        else if (t >= NA) { __syncthreads(); phase_convert(p, l, 1, t - NA); }
        else { const bool lat = t < 704; const int arg = lat ? t - 448 : t - 704;
            attn_unit(p, lat ? arg >> 6 : arg >> 3, lat ? (arg >> 3) & 7 : arg & 7, lat ? 256 + (arg & 7) * 256 : 0, lat ? 2304 : 256); }
    }
}
DEV void phase_post(const KP& p, int l) {
    const int oz = opaque0();
    const int tid = otid(), wave = __builtin_amdgcn_readfirstlane(tid >> 6), lane = tid & 63;
    const int gw = obid() * 8 + wave, NGW = gridDim.x * 8;
    const float* SC = (const float*)(wsp(p) + OFF_SC); const float* ZF = (const float*)(wsp(p) + OFF_ZF); const float* GR = (const float*)(wsp(p) + OFF_RW) + 9 * SZ_RW;
    bf16_t* AB = (bf16_t*)(wsp(p) + OFF_AB);
    for (int tau = gw; tau < MROWS * 3; tau += NGW) {
        const int row = tau / 3, kind = tau - row * 3;
        if (l == 1 && (row % TPB) < 256) continue;
        const size_t ro = (size_t)row * 512;
        if (kind == 0) {
            float o[8], s1[8];
#pragma unroll
            for (int hh = 0; hh < 8; ++hh) { const int j = hh * 64 + lane; o[hh] = SC[0 * SZ_RW + ro + j] + SC[1 * SZ_RW + ro + j]; s1[hh] = o[hh]; }
#pragma unroll
            for (int hh = 0; hh < 8; ++hh) s1[hh] = wsum(s1[hh]);
            float dl[8], s2[8];
#pragma unroll
            for (int hh = 0; hh < 8; ++hh) { dl[hh] = o[hh] - s1[hh] * (1.f / 64.f); s2[hh] = dl[hh] * dl[hh]; }
#pragma unroll
            for (int hh = 0; hh < 8; ++hh) s2[hh] = wsum(s2[hh]);
#pragma unroll
            for (int hh = 0; hh < 8; ++hh) { const int j = hh * 64 + lane; const float y = dl[hh] * (1.f / sqrtf(s2[hh] * (1.f / 64.f) + 64e-5f));
                AB[0 * SZ_RW + ro + j] = f2bf((y * p.in[oz + 21][l * 512 + j] + p.in[oz + 22][l * 512 + j]) * GR[ro + j]); }
        } else if (kind == 1) {
            float x[8], s1[4];
#pragma unroll
            for (int hh = 0; hh < 4; ++hh) {
#pragma unroll
                for (int e = 0; e < 2; ++e) { const int j = hh * 128 + e * 64 + lane;
                    x[hh * 2 + e] = sigm(ZF[(size_t)row * LD_ZF + ZF_ML + 1536 + j]) * (SC[2 * SZ_RW + ro + j] + SC[3 * SZ_RW + ro + j]); }
                s1[hh] = x[hh * 2] + x[hh * 2 + 1]; }
#pragma unroll
            for (int hh = 0; hh < 4; ++hh) s1[hh] = wsum(s1[hh]);
            float s2[4];
#pragma unroll
            for (int hh = 0; hh < 4; ++hh) { const float mean = s1[hh] * (1.f / 128.f); x[hh * 2] -= mean; x[hh * 2 + 1] -= mean; s2[hh] = x[hh * 2] * x[hh * 2] + x[hh * 2 + 1] * x[hh * 2 + 1]; }
#pragma unroll
            for (int hh = 0; hh < 4; ++hh) s2[hh] = wsum(s2[hh]);
#pragma unroll
            for (int hh = 0; hh < 4; ++hh) { const float rs = 1.f / sqrtf(s2[hh] * (1.f / 128.f) + 1e-6f);
#pragma unroll
                for (int e = 0; e < 2; ++e) { const int j = hh * 128 + e * 64 + lane; AB[1 * SZ_RW + ro + j] = f2bf(x[hh * 2 + e] * rs * p.in[oz + 26][l * 512 + j]); } }
        } else {
#pragma unroll
            for (int hh = 0; hh < 8; ++hh) { const int j = hh * 64 + lane;
                const float y = SC[4 * SZ_RW + ro + j] + SC[5 * SZ_RW + ro + j] + ZF[(size_t)row * LD_ZF + ZF_S5 + j] * p.in[oz + 34][l * 512 + j];
                const float ge = 0.5f * y * (1.f + tanhf(0.7978845608028654f * (y + 0.044715f * y * y * y)));
                AB[2 * SZ_RW + ro + j] = f2bf(ge); }
        }
    }
}

DEV void phase_gatesum(const KP& p, int skip) {
    const int tid = otid(), wave = __builtin_amdgcn_readfirstlane(tid >> 6), lane = tid & 63;
    const int gw = obid() * 8 + wave, NGW = gridDim.x * 8;
    const bf16_t* P = (const bf16_t*)(wsp(p) + OFF_P); const bf16_t* G = (const bf16_t*)(wsp(p) + OFF_G); bf16_t* Y = (bf16_t*)(wsp(p) + OFF_Y);
    for (int tk0 = gw; tk0 < MROWS * 4; tk0 += 2 * NGW) {
        u32x4 pv[2][4], gv[2][4]; bool act[2];
#pragma unroll
        for (int h2 = 0; h2 < 2; ++h2) { const int tk = tk0 + h2 * NGW; const int row = tk >> 2, col = (tk & 3) * 512 + lane * 8;
            act[h2] = tk < MROWS * 4 && !(skip && (row % TPB) < 256);
            if (act[h2]) {
#pragma unroll
                for (int br = 0; br < 4; ++br) { pv[h2][br] = *(const u32x4*)(P + ((size_t)br * MROWS + row) * 2048 + col); gv[h2][br] = *(const u32x4*)(G + (size_t)row * 8192 + br * 2048 + col); } } }
#pragma unroll
        for (int h2 = 0; h2 < 2; ++h2) { if (!act[h2]) continue;
            const int tk = tk0 + h2 * NGW; const int row = tk >> 2, col = (tk & 3) * 512 + lane * 8;
            float sacc[8];
#pragma unroll
            for (int i = 0; i < 8; ++i) sacc[i] = 0.f;
#pragma unroll
            for (int br = 0; br < 4; ++br) {
#pragma unroll
                for (int i = 0; i < 4; ++i) { sacc[2 * i] += __uint_as_float(pv[h2][br][i] << 16) * __uint_as_float(gv[h2][br][i] << 16); sacc[2 * i + 1] += __uint_as_float(pv[h2][br][i] & 0xffff0000u) * __uint_as_float(gv[h2][br][i] & 0xffff0000u); } }
            u32x4 o; o.x = pk2(sacc[0], sacc[1]); o.y = pk2(sacc[2], sacc[3]); o.z = pk2(sacc[4], sacc[5]); o.w = pk2(sacc[6], sacc[7]);
            st16(Y + (size_t)row * 2048 + col, o); }
    }
}
DEV void gsync(const KP& p) {
    XcdBarrier b; b.bar = (unsigned*)(wsp(p) + OFF_BAR); b.x = xb_xcc_id(); b.st = (volatile XB_LAS unsigned*)(XB_LAS unsigned char*)(shm + XBST_OFF);
    xcd_barrier(b);
}
__global__ void __launch_bounds__(512, 2) hybrid_fwd(KP p) {
    cg::grid_group grid = cg::this_grid();
    otid_init();
    if (otid() == 0) { volatile XB_LAS unsigned* st0 = (volatile XB_LAS unsigned*)(XB_LAS unsigned char*)(shm + XBST_OFF); st0[0] = 0u; st0[1] = 0u; }
    __syncthreads();
    (void)xcd_barrier_post((unsigned*)(wsp(p) + OFF_BAR), (volatile XB_LAS unsigned*)(XB_LAS unsigned char*)(shm + XBST_OFF));
    grid.sync();
    phase_convert(p, 0, 0, 0); phase_mod(p); phase_s5disc(p);
    gsync(p);
#pragma unroll 1
    for (int l = 0; l < 2; ++l) {
        const int oz = opaque0();
        const int skip = l;
        const float* MODL = (const float*)(wsp(p) + OFF_MOD) + (size_t)l * 5 * 12288;
        if (l == 1) { __syncthreads(); phase_convert(p, 1, 0, 0); }
        phase_norm(p, l, 0, l == 0, false, l == 1 ? (0 * 8 + 5) : -1);
        gsync(p);
        { EpiWin E{(bf16_t*)(wsp(p) + OFF_ZA), (float*)(wsp(p) + OFF_ZF)}; run_gemm((const bf16_t*)(wsp(p) + OFF_H), (const bf16_t*)(wsp(p) + OFF_W + W_WIN), 6144, 2048, 0, E); }
        gsync(p);
        phase_rwkvprep(p, l); phase_attnprep(p, l);
        gsync(p);
        phase_mix(p, l);
        gsync(p);
        phase_post(p, l);
        gsync(p);
        { EpiGlu2<0> E{(bf16_t*)(wsp(p) + OFF_AB) + 3 * SZ_RW, 512}; run_gemm((const bf16_t*)(wsp(p) + OFF_AB) + 2 * SZ_RW, (const bf16_t*)(wsp(p) + OFF_W + W_GL), 1024, 512, skip, E); }
        { EpiGate E{(bf16_t*)(wsp(p) + OFF_G), p.in[oz + 9] + (size_t)l * 8192}; run_gemm((const bf16_t*)(wsp(p) + OFF_H), (const bf16_t*)(wsp(p) + OFF_W + W_WG), 8192, 2048, skip, E, 144 % (int)gridDim.x); }
        gsync(p);
#pragma unroll 1
        for (int br = 0; br < 4; ++br) {
            EpiPlain E{(bf16_t*)(wsp(p) + OFF_P) + (size_t)br * MROWS * 2048};
            const bf16_t* A = br == 0 ? (const bf16_t*)(wsp(p) + OFF_O) : (const bf16_t*)(wsp(p) + OFF_AB) + (size_t)(br == 1 ? 0 : (br == 2 ? 1 : 3)) * SZ_RW;
            const bf16_t* Bt = (const bf16_t*)(wsp(p) + OFF_W + (br == 0 ? W_BA : (br == 1 ? W_BR : (br == 2 ? W_BM : W_BS))));
            run_gemm(A, Bt, 2048, br == 0 ? 1024 : 512, skip, E, (64 * br) % (int)gridDim.x);
        }
        gsync(p);
        phase_gatesum(p, skip);
        gsync(p);
        { EpiResid E{(float*)(wsp(p) + OFF_X), MODL + 2 * 2048}; run_gemm((const bf16_t*)(wsp(p) + OFF_Y), (const bf16_t*)(wsp(p) + OFF_W + W_WO), 2048, 2048, 1, E); }
        if (l == 0) {
#pragma unroll 1
            for (int q = 0; q < 4; ++q) { EpiPartial E{(bf16_t*)(wsp(p) + OFF_PART) + (size_t)q * 1024 * 2048}; run_gemm_ctxq((const bf16_t*)(wsp(p) + OFF_Y), (const bf16_t*)(wsp(p) + OFF_W + W_WO), 2048, 2048, q, E); } }
        gsync(p);
        phase_norm(p, l, 1, false, skip != 0, l == 0 ? (0 * 8 + 2) : -1);
        gsync(p);
        { EpiGlu2<1> E{(bf16_t*)(wsp(p) + OFF_ACT), FFN}; run_gemm((const bf16_t*)(wsp(p) + OFF_H), (const bf16_t*)(wsp(p) + OFF_W + W_FI), 11264, 2048, skip, E); }
        gsync(p);
        { EpiResid E{(float*)(wsp(p) + OFF_X), MODL + 5 * 2048}; run_gemm((const bf16_t*)(wsp(p) + OFF_ACT), (const bf16_t*)(wsp(p) + OFF_W + W_FO), 2048, FFN, 1, E); }
        if (l == 0) {
#pragma unroll 1
            for (int q = 0; q < 4; ++q) { EpiPartial E{(bf16_t*)(wsp(p) + OFF_PART) + (size_t)q * 1024 * 2048}; run_gemm_ctxq((const bf16_t*)(wsp(p) + OFF_ACT), (const bf16_t*)(wsp(p) + OFF_W + W_FO), 2048, FFN, q, E); } }
        gsync(p);
    }
    phase_final(p);
}

extern "C" void kernel_launch(void* const* d_in, const int* in_sizes, int n_in, void* d_out, int out_size, void* d_ws, size_t ws_size, hipStream_t stream) {
    static int grid = 0;
    if (grid == 0) {
        if (n_in != 44 || out_size != 4 * 2048 * 2048 || ws_size < WS_END) { fprintf(stderr, "kernel_launch: unexpected shapes: n_in %d out %d ws %zu (need %zu)\n", n_in, out_size, ws_size, (size_t)WS_END); grid = -1; return; }
        int dev = 0, cus = 0, per_cu = 0;
        hipGetDevice(&dev);
        hipDeviceGetAttribute(&cus, hipDeviceAttributeMultiprocessorCount, dev);
        if (hipFuncSetAttribute((const void*)hybrid_fwd, hipFuncAttributeMaxDynamicSharedMemorySize, LDS_BYTES) != hipSuccess) { fprintf(stderr, "kernel_launch: hipFuncSetAttribute failed\n"); grid = -1; return; }
        if (hipOccupancyMaxActiveBlocksPerMultiprocessor(&per_cu, (const void*)hybrid_fwd, 512, LDS_BYTES) != hipSuccess || per_cu < 1) { fprintf(stderr, "kernel_launch: occupancy query failed (%d)\n", per_cu); (void)hipGetLastError(); per_cu = 1; }
        grid = cus * per_cu;
        if (grid > 256) grid = 256;
    }
    if (grid < 0) return;
    KP p{};
    for (int i = 0; i < 44; ++i) p.in[i] = (const float*)d_in[i];
    p.out = (float*)d_out; p.ws = (unsigned char*)d_ws;
    (void)hipMemsetAsync((char*)d_ws + OFF_BAR, 0, 16384, stream);
    void* args[] = {&p};
    hipError_t e = hipLaunchCooperativeKernel((const void*)hybrid_fwd, dim3(grid), dim3(512), args, LDS_BYTES, stream);
    if (e != hipSuccess) fprintf(stderr, "cooperative launch failed: %s (grid %d)\n", hipGetErrorString(e), grid);
}
```
